# Optimizing an MI355X kernel written in HIP

```python
import jax
import jax.numpy as jnp
from jax import lax
import numpy as np

D_MODEL = 2048
BATCH = 8
SEQ = 2048
DEPTH = 2

GRID_W = 64
CTX_LEN = 256
EPS = 1e-6

NA_HEAD_DIM = 128
NA_HEADS = D_MODEL // 256
NA_WIDTH = NA_HEADS * NA_HEAD_DIM
NA_WIN_ROWS = 8
NA_WIN_COLS = 16
NA_QCOL_BLOCK = 16
NA_KCOL_BLOCK = NA_QCOL_BLOCK + NA_WIN_COLS

HG_HEADS = D_MODEL // 512
HG_KEY_DIM = 128
HG_VAL_DIM = 128
HG_KEY_WIDTH = HG_HEADS * HG_KEY_DIM
HG_WIDTH = HG_HEADS * HG_VAL_DIM
HG_CHUNK = 64

GM_GROUPS = D_MODEL // 512
GM_GROUP_DIM = 128
GM_WIDTH = GM_GROUPS * GM_GROUP_DIM
GM_CHUNK = 128

MIX_WIDTH = NA_WIDTH + HG_WIDTH + GM_WIDTH
IN_SPLITS = [NA_WIDTH] * 3 + [HG_KEY_WIDTH] * 3 + [HG_WIDTH] * 2 + [GM_WIDTH] * 2
IN_WIDTH = sum(IN_SPLITS)
MLP_HIDDEN = 4 * D_MODEL

kernel_name = "hybrid_na_hgrn2_gmlp_dit_trunk"


def _rmsnorm(x, w):
    xf = x.astype(jnp.float32)
    y = xf * lax.rsqrt(jnp.mean(xf * xf, axis=-1, keepdims=True) + EPS)
    return (y * w.astype(jnp.float32)).astype(x.dtype)


def _ada(cond, w, b):
    m = jnp.einsum('...d,de->...e', jax.nn.silu(cond), w) + b
    return jnp.split(m[..., None, :], 6, axis=-1)


def _modulate(h, shift, scale):
    return h * (1 + scale) + shift


def _split_heads(t, h):
    bsz, n, _ = t.shape
    return t.reshape(bsz, n, h, -1).transpose(0, 2, 1, 3)


def _merge_heads(t):
    bsz, h, n, d = t.shape
    return t.transpose(0, 2, 1, 3).reshape(bsz, n, h * d)


def _dense_attention(q, k, v):
    s = jnp.einsum('bhqd,bhkd->bhqk', q, k).astype(jnp.float32) * (q.shape[-1] ** -0.5)
    p = jax.nn.softmax(s, axis=-1).astype(v.dtype)
    return jnp.einsum('bhqk,bhkd->bhqd', p, v)


def _na_latent(q, k, v, k_ctx, v_ctx, rpb):
    bsz, h, t, dh = q.shape
    rows = t // GRID_W
    kr = min(NA_WIN_ROWS, rows)
    n_cb = GRID_W // NA_QCOL_BLOCK
    scale = dh ** -0.5
    qcol = np.arange(GRID_W).reshape(n_cb, NA_QCOL_BLOCK)
    kstart = np.clip(np.arange(n_cb) * NA_QCOL_BLOCK - NA_WIN_COLS // 2, 0, GRID_W - NA_KCOL_BLOCK)
    kcol = kstart[:, None] + np.arange(NA_KCOL_BLOCK)[None, :]
    wstart = np.clip(qcol - NA_WIN_COLS // 2, 0, GRID_W - NA_WIN_COLS)
    col_valid = (kcol[:, None, :] >= wstart[:, :, None]) & (kcol[:, None, :] < wstart[:, :, None] + NA_WIN_COLS)
    dcol = np.clip(kcol[:, None, :] - qcol[:, :, None], 1 - NA_WIN_COLS, NA_WIN_COLS - 1) + NA_WIN_COLS - 1
    col_bias = rpb.astype(jnp.float32)[:, :, dcol]
    qg = q.reshape(bsz, h, rows, n_cb, NA_QCOL_BLOCK, dh)
    kg = k.reshape(bsz, h, rows, GRID_W, dh)
    vg = v.reshape(bsz, h, rows, GRID_W, dh)
    n_lat = kr * NA_KCOL_BLOCK

    def row_block(r):
        r0 = jnp.clip(r - kr // 2, 0, rows - kr)
        q_r = lax.dynamic_index_in_dim(qg, r, axis=2, keepdims=False)
        k_r = lax.dynamic_slice_in_dim(kg, r0, kr, axis=2)[:, :, :, kcol]
        v_r = lax.dynamic_slice_in_dim(vg, r0, kr, axis=2)[:, :, :, kcol]
        s_lat = jnp.einsum('bhjqd,bhrjkd->bhjqrk', q_r, k_r).astype(jnp.float32) * scale
        drow = r0 + jnp.arange(kr) - r + (NA_WIN_ROWS - 1)
        bias = jnp.take(col_bias, drow, axis=1).transpose(0, 2, 3, 1, 4)
        s_lat = jnp.where(col_valid[:, :, None, :], s_lat + bias, -jnp.inf)
        s_ctx = jnp.einsum('bhjqd,bhcd->bhjqc', q_r, k_ctx).astype(jnp.float32) * scale
        s_all = jnp.concatenate([s_lat.reshape(bsz, h, n_cb, NA_QCOL_BLOCK, n_lat), s_ctx], axis=-1)
        p = jax.nn.softmax(s_all, axis=-1).astype(v.dtype)
        p_lat = p[..., :n_lat].reshape(bsz, h, n_cb, NA_QCOL_BLOCK, kr, NA_KCOL_BLOCK)
        o = (jnp.einsum('bhjqrk,bhrjkd->bhjqd', p_lat, v_r)
             + jnp.einsum('bhjqc,bhcd->bhjqd', p[..., n_lat:], v_ctx))
        return o.reshape(bsz, h, GRID_W, dh)

    o = lax.map(row_block, jnp.arange(rows))
    return o.transpose(1, 2, 0, 3, 4).reshape(bsz, h, t, dh)


def _forget_gate(f_logits, lb):
    lb = lb.reshape(HG_HEADS, 1, HG_KEY_DIM).astype(jnp.float32)
    log_f = jnp.logaddexp(jnp.log(lb), jnp.log1p(-lb) + jax.nn.log_sigmoid(f_logits))
    return log_f, -jnp.expm1(log_f)


def _gla_chunk_scan(q, k, v, log_f, s0):
    bsz, h, t, dk = q.shape
    dv = v.shape[-1]
    n = t // HG_CHUNK

    def chunks(a):
        return a.reshape(bsz, h, n, HG_CHUNK, a.shape[-1]).transpose(2, 0, 1, 3, 4)

    incl = np.tril(np.ones((HG_CHUNK, HG_CHUNK), dtype=bool))[:, :, None]

    def step(s, xs):
        qc, kc, vc, gc = xs
        b = jnp.cumsum(gc, axis=2)
        diff = b[:, :, :, None, :] - b[:, :, None, :, :]
        decay = jnp.exp(jnp.where(incl, diff, -jnp.inf))
        att = jnp.einsum('bhtd,bhsd,bhtsd->bhts', qc, kc, decay)
        o = (jnp.einsum('bhts,bhsv->bhtv', att, vc)
             + jnp.einsum('bhtd,bhdv->bhtv', qc * jnp.exp(b), s))
        b_end = b[:, :, -1:, :]
        s_new = (jnp.exp(b_end[:, :, 0, :, None]) * s
                 + jnp.einsum('bhsd,bhsv->bhdv', kc * jnp.exp(b_end - b), vc))
        return s_new, o

    s_fin, o = lax.scan(step, s0, (chunks(q), chunks(k), chunks(v), chunks(log_f)))
    return o.transpose(1, 2, 0, 3, 4).reshape(bsz, h, t, dv), s_fin


def _gate_norm(o, g, w):
    o = o * lax.rsqrt(jnp.mean(o * o, axis=-1, keepdims=True) + EPS) * w.astype(jnp.float32)
    return (_merge_heads(o) * jax.nn.silu(g.astype(jnp.float32))).astype(g.dtype)


def _hgrn2(parts_c, parts_l, lb_fw, lb_bw, norm_w, need_ctx):
    scale = HG_KEY_DIM ** -0.5

    def prep(parts):
        q, f_fw, f_bw, i, g = parts
        hk = lambda t: _split_heads(t, HG_HEADS).astype(jnp.float32)
        return jax.nn.silu(hk(q)) * scale, hk(f_fw), hk(f_bw), hk(i), g

    qc, fwc, bwc, ic, gc = prep(parts_c)
    ql, fwl, bwl, il, gl = prep(parts_l)
    flip = lambda a: jnp.flip(a, axis=2)
    outs_c, outs_l = [], []
    for fc, fl, lb, rev in ((fwc, fwl, lb_fw, False), (bwc, bwl, lb_bw, True)):
        logf_c, k_c = _forget_gate(fc, lb)
        logf_l, k_l = _forget_gate(fl, lb)
        seq_c = (qc, k_c, ic, logf_c)
        seq_l = (ql, k_l, il, logf_l)
        if rev:
            seq_c = tuple(flip(a) for a in seq_c)
            seq_l = tuple(flip(a) for a in seq_l)
        s0 = jnp.zeros((qc.shape[0], HG_HEADS, HG_KEY_DIM, HG_VAL_DIM), jnp.float32)
        o_c, s_ctx = _gla_chunk_scan(seq_c[0], seq_c[1], seq_c[2], seq_c[3], s0)
        o_l, _ = _gla_chunk_scan(seq_l[0], seq_l[1], seq_l[2], seq_l[3], s_ctx)
        if rev:
            o_c, o_l = flip(o_c), flip(o_l)
        outs_c.append(o_c)
        outs_l.append(o_l)
    out_l = _gate_norm(outs_l[0] + outs_l[1], gl, norm_w)
    out_c = _gate_norm(outs_c[0] + outs_c[1], gc, norm_w) if need_ctx else None
    return out_c, out_l


def _chunk_gmlp(u, v, ln_w, ws, bs):
    bsz, t, _ = u.shape
    n = t // GM_CHUNK
    uf = jax.nn.gelu(u.astype(jnp.float32))
    vf = jax.nn.gelu(v.astype(jnp.float32)).reshape(bsz, n, GM_CHUNK, GM_GROUPS, GM_GROUP_DIM)
    mu = jnp.mean(vf, axis=-1, keepdims=True)
    var = jnp.mean(jnp.square(vf - mu), axis=-1, keepdims=True)
    vn = (vf - mu) * lax.rsqrt(var + EPS) * ln_w.astype(jnp.float32).reshape(GM_GROUPS, GM_GROUP_DIM)
    mixed = jnp.einsum('gpq,bnqgd->bnpgd', ws.astype(jnp.float32), vn) + bs.astype(jnp.float32).T[:, :, None]
    return (uf * mixed.reshape(bsz, t, GM_WIDTH)).astype(u.dtype)


def _token_mixers(hc, hl, w_in, w_out, rpb, lb_fw, lb_bw, hg_norm_w, gm_ln_w, gm_ws, gm_bs, need_ctx):
    dt = hl.dtype
    idx = np.cumsum(IN_SPLITS)[:-1].tolist()
    pc = jnp.split(jnp.einsum('btd,de->bte', hc, w_in), idx, axis=-1)
    pl = jnp.split(jnp.einsum('btd,de->bte', hl, w_in), idx, axis=-1)
    ka_c, va_c = _split_heads(pc[1], NA_HEADS), _split_heads(pc[2], NA_HEADS)
    oa_l = _na_latent(_split_heads(pl[0], NA_HEADS), _split_heads(pl[1], NA_HEADS),
                      _split_heads(pl[2], NA_HEADS), ka_c, va_c, rpb)
    ob_c, ob_l = _hgrn2(pc[3:8], pl[3:8], lb_fw, lb_bw, hg_norm_w, need_ctx)
    oc_l = _chunk_gmlp(pl[8], pl[9], gm_ln_w, gm_ws, gm_bs)
    y_l = jnp.einsum('bte,ed->btd', jnp.concatenate([_merge_heads(oa_l).astype(dt), ob_l.astype(dt), oc_l.astype(dt)], axis=-1), w_out)
    if not need_ctx:
        return None, y_l
    oa_c = _dense_attention(_split_heads(pc[0], NA_HEADS), ka_c, va_c)
    oc_c = _chunk_gmlp(pc[8], pc[9], gm_ln_w, gm_ws, gm_bs)
    y_c = jnp.einsum('bte,ed->btd', jnp.concatenate([_merge_heads(oa_c).astype(dt), ob_c.astype(dt), oc_c.astype(dt)], axis=-1), w_out)
    return y_c, y_l


def _sq_relu_mlp(h, w1, w2):
    a = jax.nn.relu(jnp.einsum('btd,df->btf', h, w1))
    return jnp.einsum('btf,fd->btd', a * a, w2)


def setup_inputs(seed: int = 0) -> dict:
    key = jax.random.key(seed)
    ks = jax.random.split(key, 19)
    nrm = jax.random.normal
    f32 = jnp.float32
    d = D_MODEL
    return {
        "x": nrm(ks[0], (BATCH, SEQ, d), f32),
        "c": nrm(ks[1], (BATCH, d), f32),
        "ctx": nrm(ks[2], (BATCH, CTX_LEN, d), f32),
        "c_ctx": nrm(ks[3], (d,), f32),
        "ada_w": nrm(ks[4], (DEPTH, d, 6 * d), f32) * (0.5 * d ** -0.5),
        "ada_b": 0.02 * nrm(ks[5], (DEPTH, 6 * d), f32),
        "norm1_w": 1.0 + 0.02 * nrm(ks[6], (DEPTH, d), f32),
        "norm2_w": 1.0 + 0.02 * nrm(ks[7], (DEPTH, d), f32),
        "w_in": nrm(ks[8], (DEPTH, d, IN_WIDTH), f32) * d ** -0.5,
        "na_rpb": 0.1 * nrm(ks[9], (DEPTH, NA_HEADS, 2 * NA_WIN_ROWS - 1, 2 * NA_WIN_COLS - 1), f32),
        "hg_lb_logits": 0.5 * nrm(ks[10], (DEPTH, 2, HG_KEY_WIDTH), f32),
        "hg_norm_w": 1.0 + 0.02 * nrm(ks[11], (DEPTH, HG_VAL_DIM), f32),
        "gm_ln_w": 1.0 + 0.02 * nrm(ks[12], (DEPTH, GM_WIDTH), f32),
        "gm_ws": nrm(ks[13], (DEPTH, GM_GROUPS, GM_CHUNK, GM_CHUNK), f32) * GM_CHUNK ** -0.5,
        "gm_bs": 1.0 + 0.02 * nrm(ks[14], (DEPTH, GM_GROUPS, GM_CHUNK), f32),
        "w_out": nrm(ks[15], (DEPTH, MIX_WIDTH, d), f32) * MIX_WIDTH ** -0.5,
        "mlp_w1": nrm(ks[16], (DEPTH, d, MLP_HIDDEN), f32) * d ** -0.5,
        "mlp_w2": nrm(ks[17], (DEPTH, MLP_HIDDEN, d), f32) * MLP_HIDDEN ** -0.5,
        "final_norm_w": 1.0 + 0.02 * nrm(ks[18], (d,), f32),
    }


def reference(x, c, ctx, c_ctx, ada_w, ada_b, norm1_w, norm2_w, w_in, na_rpb, hg_lb_logits,
              hg_norm_w, gm_ln_w, gm_ws, gm_bs, w_out, mlp_w1, mlp_w2, final_norm_w):
    lb_all = jnp.cumsum(jax.nn.softmax(hg_lb_logits.astype(jnp.float32), axis=0), axis=0)
    lb_all = lb_all - lb_all[:1]
    for l in range(DEPTH):
        need_ctx = l < DEPTH - 1
        sh1, sc1, g1, sh2, sc2, g2 = _ada(c, ada_w[l], ada_b[l])
        csh1, csc1, cg1, csh2, csc2, cg2 = _ada(c_ctx, ada_w[l], ada_b[l])
        hl = _modulate(_rmsnorm(x, norm1_w[l]), sh1, sc1)
        hc = _modulate(_rmsnorm(ctx, norm1_w[l]), csh1, csc1)
        y_c, y_l = _token_mixers(hc, hl, w_in[l], w_out[l], na_rpb[l], lb_all[l, 0], lb_all[l, 1],
                                 hg_norm_w[l], gm_ln_w[l], gm_ws[l], gm_bs[l], need_ctx)
        x = x + g1 * y_l
        x = x + g2 * _sq_relu_mlp(_modulate(_rmsnorm(x, norm2_w[l]), sh2, sc2), mlp_w1[l], mlp_w2[l])
        if need_ctx:
            ctx = ctx + cg1 * y_c
            ctx = ctx + cg2 * _sq_relu_mlp(_modulate(_rmsnorm(ctx, norm2_w[l]), csh2, csc2), mlp_w1[l], mlp_w2[l])
    return _rmsnorm(x, final_norm_w)
```

```cpp
#include <hip/hip_runtime.h>
#include <hip/hip_cooperative_groups.h>
#include <cstdio>
namespace cg = cooperative_groups;

#ifndef ONE_LAUNCH
#define ONE_LAUNCH 0
#endif

#define LAS __attribute__((address_space(3)))
typedef unsigned short bf16_t;
typedef short bf16x8 __attribute__((ext_vector_type(8)));
typedef short s16x4 __attribute__((ext_vector_type(4)));
typedef float f32x4 __attribute__((ext_vector_type(4)));
typedef unsigned u32x4 __attribute__((ext_vector_type(4)));
typedef unsigned u32x2 __attribute__((ext_vector_type(2)));

constexpr int DM = 2048, NB = 8, TL = 2048, CT = 256, ML = NB * TL, MC = NB * CT, MT = ML + MC;
constexpr int NIN = 6656, HID = 8192;
constexpr size_t WT_IN = 0, WT_OUT = (size_t)NIN * DM, WT_1 = WT_OUT + (size_t)DM * DM, WT_2 = WT_1 + (size_t)HID * DM, WT_LAYER = WT_2 + (size_t)DM * HID;
constexpr int LDS_BYTES = 131072;
constexpr int NPHASE = 18;
constexpr int C_NAQ = 0, C_NAK = 1024, C_NAV = 2048, C_HQ = 3072, C_HF = 3584, C_HI = 4608, C_HG = 5120, C_GU = 5632, C_GV = 6144;

struct Params {
    const float *x, *c, *ctx, *c_ctx, *ada_w, *ada_b, *n1w, *n2w, *w_in, *rpb, *lb_logits, *hg_nw, *gm_lnw, *gm_ws, *gm_bs, *w_out, *w1, *w2, *fnw;
    float* out;
    float* xc;
    bf16_t* wt;
    bf16_t* h;
    bf16_t* mix;
    bf16_t* big;
    float* mod;
};

__device__ __forceinline__ unsigned cvt_pk_bf16(float lo, float hi) { unsigned r; asm("v_cvt_pk_bf16_f32 %0, %1, %2" : "=v"(r) : "v"(lo), "v"(hi)); return r; }
__device__ __forceinline__ float bf2f(bf16_t b) { return __uint_as_float(((unsigned)b) << 16); }
__device__ __forceinline__ float bflo(unsigned w) { return __uint_as_float(w << 16); }
__device__ __forceinline__ float bfhi(unsigned w) { return __uint_as_float(w & 0xffff0000u); }
__device__ __forceinline__ bf16_t f2bf(float f) { return (bf16_t)(cvt_pk_bf16(f, 0.f) & 0xffffu); }
__device__ __forceinline__ int tid_o() { int t = (int)threadIdx.x; asm volatile("" : "+v"(t)); return t; }
__device__ __forceinline__ int bid_o() { int t = (int)blockIdx.x; asm volatile("" : "+s"(t)); return t; }
__device__ __forceinline__ float gelu_tanh(float x) { const float z = 0.7978845608028654f * (x + 0.044715f * x * x * x); return x / (1.0f + __expf(-2.0f * z)); }
__device__ __forceinline__ float silu_f(float x) { return x / (1.0f + __expf(-x)); }

namespace pg8 {
constexpr int BM = 256, BK = 64, HALF = 128, HTB = HALF * BK * 2, STAGE_BYTES = 8 * HTB, NXCD = 8, WGM = 8;
__device__ __forceinline__ int lds_byte(int r, int c) { const int st = (r >> 4) * 2 + (c >> 5), rr = r & 15, cc = c & 31, ob = rr * 64 + cc * 2; return st * 1024 + (ob ^ (((ob >> 9) & 1) << 5)); }
__device__ __forceinline__ void stage_rc(int b, int& R, int& C) { const int st = b / 1024, sb = b % 1024, swz = sb ^ (((sb >> 9) & 1) << 5); R = (st >> 1) * 16 + swz / 64; C = (st & 1) * 32 + (swz % 64) / 2; }
__device__ __forceinline__ int perm32(int rho) { const int n = rho >> 4, i = rho & 15; return 8 * (i >> 2) + 4 * n + (i & 3); }
struct Unit { int pm, pn; };
struct Gemm { const bf16_t* A; const bf16_t* Bt; int M, N, K; };
struct StaticOrder {
    int nM, nN, nwg, G, c;
    __device__ void init(int M, int N, int G_, int c_) { nM = M / BM; nN = N / BM; nwg = nM * nN; G = G_; c = c_; }
    __device__ bool next(int i, Unit& u) const {
        const long L = (long)i * G + c; if (L >= nwg) return false;
        int wgid = (int)L; { const int q = nwg / NXCD, r = nwg % NXCD, xcd = wgid % NXCD, off = wgid / NXCD; wgid = (xcd < r ? xcd * (q + 1) : r * (q + 1) + (xcd - r) * q) + off; }
        const int nig = WGM * nN, gid = wgid / nig, fm = gid * WGM, gsz = (nM - fm) < WGM ? (nM - fm) : WGM;
        u.pm = fm + ((wgid % nig) % gsz); u.pn = (wgid % nig) / gsz; return true;
    }
};

template <int ACT  > struct EpiBf16 {
    static constexpr bool PERM = true;
    bf16_t* O; int ldc;
    __device__ __forceinline__ void operator()(const f32x4 (&acc)[2][2][4][2], const Unit& u, int wr, int wc, int fr, int fq) const {
        const int row0 = u.pm * BM + wr * 64 + fr, col0 = u.pn * BM + wc * 32 + 8 * fq;
#pragma unroll
        for (int ai = 0; ai < 2; ++ai)
#pragma unroll
            for (int m = 0; m < 4; ++m) { bf16_t* rowp = O + (size_t)(row0 + ai * HALF + m * 16) * ldc + col0;
#pragma unroll
                for (int bj = 0; bj < 2; ++bj) { f32x4 v0 = acc[ai][bj][m][0], v1 = acc[ai][bj][m][1];
                    if (ACT == 1) {
#pragma unroll
                        for (int j = 0; j < 4; ++j) { float a = fmaxf(v0[j], 0.f), b = fmaxf(v1[j], 0.f); v0[j] = a * a; v1[j] = b * b; } }
                    u32x4 w; w.x = cvt_pk_bf16(v0[0], v0[1]); w.y = cvt_pk_bf16(v0[2], v0[3]); w.z = cvt_pk_bf16(v1[0], v1[1]); w.w = cvt_pk_bf16(v1[2], v1[3]);
                    *(u32x4*)(rowp + bj * HALF) = w; } }
    }
};
struct EpiRes {
    static constexpr bool PERM = false;
    const float* src_lat; const float* src_ctx; float* dst_lat; float* dst_ctx; const float* gate;
    __device__ __forceinline__ void operator()(const f32x4 (&acc)[2][2][4][2], const Unit& u, int wr, int wc, int fr, int fq) const {
        const bool lat = u.pm < 64; const int r = lat ? (u.pm >> 3) : 8;
        const float* s = lat ? src_lat : src_ctx; float* d = lat ? dst_lat : dst_ctx;
        const int row0 = (lat ? u.pm : u.pm - 64) * BM + wr * 64 + fr, col0 = u.pn * BM + wc * 32 + 4 * fq;
        const float* g = gate + (size_t)r * 12288 + col0;
        f32x4 gv[2][2];
#pragma unroll
        for (int bj = 0; bj < 2; ++bj)
#pragma unroll
            for (int n = 0; n < 2; ++n) gv[bj][n] = *(const f32x4*)(g + bj * HALF + n * 16);
#pragma unroll
        for (int ai = 0; ai < 2; ++ai)
#pragma unroll
            for (int m = 0; m < 4; ++m) { const size_t off = (size_t)(row0 + ai * HALF + m * 16) * DM + col0;
#pragma unroll
                for (int bj = 0; bj < 2; ++bj)
#pragma unroll
                    for (int n = 0; n < 2; ++n) { const f32x4 xv = *(const f32x4*)(s + off + bj * HALF + n * 16); *(f32x4*)(d + off + bj * HALF + n * 16) = xv + gv[bj][n] * acc[ai][bj][m][n]; } }
    }
};

template <class Epi, class Sched>
__device__ __forceinline__ void gemm_phase(LAS unsigned char* lds, const Gemm g, const Sched& S, const Epi& E) {
    const int tid = tid_o(), wid = __builtin_amdgcn_readfirstlane(tid >> 6), lane = tid & 63, wr = wid >> 2, wc = wid & 3, fr = lane & 15, fq = lane >> 4;
    const int K = g.K, nt = K / BK;
    unsigned voffA[2], voffB[2];
#pragma unroll
    for (int i = 0; i < 2; ++i) { int R, C; stage_rc(tid * 16 + i * 8192, R, C); const int Rb = Epi::PERM ? ((R & ~31) + perm32(R & 31)) : R;
        voffA[i] = (unsigned)(R * K + C) * 2u; voffB[i] = (unsigned)(Rb * K + C) * 2u; }
    const size_t kstep = (size_t)(BK * 2);
    const size_t hstep = (size_t)HALF * K * 2;
    const size_t tstep = 2 * hstep;
    const unsigned ldsw = (unsigned)wid * 1024u;
    const int aoff = lds_byte(wr * 64 + fr, fq * 8), boff = lds_byte(wc * 32 + fr, fq * 8);
#define PG8_SA(b, h) (((b) * 2 + (h)) * HTB)
#define PG8_SB(b, h) ((4 + (b) * 2 + (h)) * HTB)
#define PG8_STAGE(bufoff, gbase, voff) do { _Pragma("unroll") for (int _i = 0; _i < 2; ++_i) \
        __builtin_amdgcn_global_load_lds((const unsigned*)((const char*)(gbase) + (voff)[_i]), (LAS unsigned*)(lds + (bufoff) + ldsw + _i * 8192), 16, 0, 0); } while (0)
#define PG8_LDA(dst, b, h) do { _Pragma("unroll") for (int m = 0; m < 4; ++m) _Pragma("unroll") for (int k = 0; k < 2; ++k) dst[m][k] = *(const LAS bf16x8*)(lds + PG8_SA(b, h) + aoff + m * 2048 + k * 1024); } while (0)
#define PG8_LDB(dst, b, h) do { _Pragma("unroll") for (int n = 0; n < 2; ++n) _Pragma("unroll") for (int k = 0; k < 2; ++k) dst[n][k] = *(const LAS bf16x8*)(lds + PG8_SB(b, h) + boff + n * 2048 + k * 1024); } while (0)
#define PG8_MMA(ai, bj, At, Bt) do { __builtin_amdgcn_s_setprio(1); _Pragma("unroll") for (int m = 0; m < 4; ++m) _Pragma("unroll") for (int n = 0; n < 2; ++n) _Pragma("unroll") for (int k = 0; k < 2; ++k) \
        acc[ai][bj][m][n] = __builtin_amdgcn_mfma_f32_16x16x32_bf16(Bt[n][k], At[m][k], acc[ai][bj][m][n], 0, 0, 0); __builtin_amdgcn_s_setprio(0); } while (0)
#define PG8_WAIT_V(n) asm volatile("s_waitcnt vmcnt(" #n ")" ::: "memory")
#define PG8_WAIT_L(n) asm volatile("s_waitcnt lgkmcnt(" #n ")" ::: "memory")
#define PG8_BAR __builtin_amdgcn_s_barrier()
#define PG8_SCHED __builtin_amdgcn_sched_barrier(0)
    Unit cur, nxt; int ui = 0;
    if (!S.next(0, cur)) return;
    f32x4 acc[2][2][4][2];
#pragma unroll
    for (int a = 0; a < 2; ++a)
#pragma unroll
        for (int b = 0; b < 2; ++b)
#pragma unroll
            for (int m = 0; m < 4; ++m)
#pragma unroll
                for (int n = 0; n < 2; ++n) acc[a][b][m][n] = (f32x4){0.f, 0.f, 0.f, 0.f};
    bf16x8 At[4][2], B0[2][2], B1[2][2];
    const char* cA = (const char*)g.A + (size_t)cur.pm * tstep; const char* cB = (const char*)g.Bt + (size_t)cur.pn * tstep;
    PG8_STAGE(PG8_SB(0, 0), cB, voffB); PG8_STAGE(PG8_SA(0, 0), cA, voffA); PG8_STAGE(PG8_SB(0, 1), cB + hstep, voffB); PG8_STAGE(PG8_SA(0, 1), cA + hstep, voffA);
    if (wr == 1) PG8_BAR;
    PG8_WAIT_V(4); PG8_BAR;
    PG8_STAGE(PG8_SB(1, 0), cB + kstep, voffB); PG8_STAGE(PG8_SA(1, 0), cA + kstep, voffA); PG8_STAGE(PG8_SB(1, 1), cB + hstep + kstep, voffB);
    PG8_WAIT_V(6); PG8_BAR;
    for (;;) {
        const bool has_next = S.next(ui + 1, nxt);
        const char* nA = has_next ? (const char*)g.A + (size_t)nxt.pm * tstep : cA; const char* nB = has_next ? (const char*)g.Bt + (size_t)nxt.pn * tstep : cB;
        for (int t = 0; t < nt; t += 2) {
            const bool last = (t == nt - 2);
            const char* a1 = cA + (size_t)(t + 1) * kstep;
            const char* a2 = last ? nA : cA + (size_t)(t + 2) * kstep; const char* b2 = last ? nB : cB + (size_t)(t + 2) * kstep;
            const char* a3 = a2 + kstep; const char* b3 = b2 + kstep;
            PG8_LDB(B0, 0, 0); PG8_SCHED; PG8_LDA(At, 0, 0); PG8_STAGE(PG8_SA(1, 1), a1 + hstep, voffA);
            PG8_WAIT_L(8); PG8_BAR; PG8_WAIT_L(0); PG8_MMA(0, 0, At, B0); PG8_BAR; PG8_SCHED;
            PG8_LDB(B1, 0, 1); PG8_STAGE(PG8_SB(0, 0), b2, voffB);
            PG8_BAR; PG8_WAIT_L(0); PG8_MMA(0, 1, At, B1); PG8_BAR;
            PG8_LDA(At, 0, 1); PG8_STAGE(PG8_SA(0, 0), a2, voffA);
            PG8_BAR; PG8_WAIT_L(0); PG8_MMA(1, 0, At, B0); PG8_BAR; PG8_SCHED;
            PG8_STAGE(PG8_SB(0, 1), b2 + hstep, voffB);
            PG8_WAIT_V(6); PG8_BAR; PG8_MMA(1, 1, At, B1); PG8_BAR;
            PG8_LDB(B0, 1, 0); PG8_SCHED; PG8_LDA(At, 1, 0); PG8_STAGE(PG8_SA(0, 1), a2 + hstep, voffA);
            PG8_WAIT_L(8); PG8_BAR; PG8_WAIT_L(0); PG8_MMA(0, 0, At, B0); PG8_BAR; PG8_SCHED;
            PG8_LDB(B1, 1, 1); PG8_STAGE(PG8_SB(1, 0), b3, voffB);
            PG8_BAR; PG8_WAIT_L(0); PG8_MMA(0, 1, At, B1); PG8_BAR;
            PG8_LDA(At, 1, 1); PG8_STAGE(PG8_SA(1, 0), a3, voffA);
            PG8_BAR; PG8_WAIT_L(0); PG8_MMA(1, 0, At, B0); PG8_BAR; PG8_SCHED;
            PG8_STAGE(PG8_SB(1, 1), b3 + hstep, voffB);
            PG8_WAIT_V(6); PG8_BAR; PG8_MMA(1, 1, At, B1); PG8_BAR;
        }
        E(acc, cur, wr, wc, fr, fq);
        if (!has_next) break;
#pragma unroll
        for (int a = 0; a < 2; ++a)
#pragma unroll
            for (int b = 0; b < 2; ++b)
#pragma unroll
                for (int m = 0; m < 4; ++m)
#pragma unroll
                    for (int n = 0; n < 2; ++n) acc[a][b][m][n] = (f32x4){0.f, 0.f, 0.f, 0.f};
        cur = nxt; cA = nA; cB = nB; ++ui;
    }
    PG8_WAIT_V(0);
    if (wr == 0) PG8_BAR;
    PG8_BAR;
#undef PG8_SA
#undef PG8_SB
#undef PG8_STAGE
#undef PG8_LDA
#undef PG8_LDB
#undef PG8_MMA
#undef PG8_WAIT_V
#undef PG8_WAIT_L
#undef PG8_BAR
#undef PG8_SCHED
}
}

template <class Epi>
__device__ __forceinline__ void run_gemm(LAS unsigned char* lds, const bf16_t* A, const bf16_t* Bt, int M, int N, int K, const Epi& E) {
    pg8::Gemm g; g.A = A; g.Bt = Bt; g.M = M; g.N = N; g.K = K;
    pg8::StaticOrder S; S.init(M, N, (int)gridDim.x, bid_o());
    pg8::gemm_phase(lds, g, S, E);
    __syncthreads();
}

__device__ void ada_items(const Params& p, LAS unsigned char* lds) {
    if (blockIdx.x >= 192) return;
    LAS float* sc = (LAS float*)lds;
    LAS float* red = sc + 9 * 2048;
    const int tid = tid_o();
    for (int i = tid; i < 9 * 2048; i += 512) { const int r = i >> 11, d = i & 2047; const float v = r < 8 ? p.c[r * 2048 + d] : p.c_ctx[d]; sc[i] = silu_f(v); }
    __syncthreads();
    for (int item = bid_o(); item < 192; item += gridDim.x) {
        const int l = item / 96, cb = item % 96, tx = tid & 31, ty = tid >> 5;
        const float* W = p.ada_w + (size_t)l * 2048 * 12288 + cb * 128 + tx * 4;
        f32x4 acc[9];
#pragma unroll
        for (int r = 0; r < 9; ++r) acc[r] = (f32x4){0.f, 0.f, 0.f, 0.f};
#pragma unroll 8
        for (int dd = 0; dd < 128; ++dd) { const int d = ty * 128 + dd; const f32x4 w = *(const f32x4*)(W + (size_t)d * 12288);
#pragma unroll
            for (int r = 0; r < 9; ++r) acc[r] += sc[r * 2048 + d] * w; }
#pragma unroll
        for (int r = 0; r < 9; ++r)
#pragma unroll
            for (int j = 0; j < 4; ++j) acc[r][j] += __shfl_xor(acc[r][j], 32);
        if ((tid & 32) == 0) { const int wave = tid >> 6;
#pragma unroll
            for (int r = 0; r < 9; ++r) *(LAS f32x4*)&red[(wave * 9 + r) * 128 + tx * 4] = acc[r]; }
        __syncthreads();
        for (int o = tid; o < 9 * 128; o += 512) { const int r = o >> 7, cc = o & 127; float s = 0.f;
#pragma unroll
            for (int w = 0; w < 8; ++w) s += red[(w * 9 + r) * 128 + cc];
            p.mod[((size_t)l * 9 + r) * 12288 + cb * 128 + cc] = s + p.ada_b[l * 12288 + cb * 128 + cc]; }
        __syncthreads();
    }
}

__device__ __forceinline__ void transpose_tile(const float* W, int K, int N, bf16_t* Wt, int tk, int tn, LAS float* tile) {
    const int tid = tid_o();
    {
        const int kr = tid >> 5, n4 = tid & 31;
        f32x4 v[8];
#pragma unroll
        for (int i = 0; i < 8; ++i) v[i] = *(const f32x4*)(W + (size_t)(tk * 128 + kr + 16 * i) * N + tn * 128 + n4 * 4);
#pragma unroll
        for (int i = 0; i < 8; ++i) { LAS float* t = tile + (kr + 16 * i) * 129 + n4 * 4; t[0] = v[i][0]; t[1] = v[i][1]; t[2] = v[i][2]; t[3] = v[i][3]; }
    }
    __syncthreads();
    {
        const int nr = tid >> 4, k8 = tid & 15;
#pragma unroll
        for (int i = 0; i < 4; ++i) { const int n = nr + 32 * i; float f[8];
#pragma unroll
            for (int j = 0; j < 8; ++j) f[j] = tile[(k8 * 8 + j) * 129 + n];
            u32x4 w; w.x = cvt_pk_bf16(f[0], f[1]); w.y = cvt_pk_bf16(f[2], f[3]); w.z = cvt_pk_bf16(f[4], f[5]); w.w = cvt_pk_bf16(f[6], f[7]);
            *(u32x4*)(Wt + (size_t)(tn * 128 + n) * K + tk * 128 + k8 * 8) = w; }
    }
    __syncthreads();
}
__device__ void prepass(const Params& p, LAS unsigned char* lds) {
    ada_items(p, lds);
    __syncthreads();
    LAS float* tile = (LAS float*)lds;
    for (int it = bid_o(); it < 2 * 3136; it += gridDim.x) {
        const int l = it / 3136; int r = it % 3136;
        const float* W; int K, N; size_t off;
        if (r < 832) { W = p.w_in + (size_t)l * DM * NIN; K = DM; N = NIN; off = WT_IN; }
        else if (r < 1088) { r -= 832; W = p.w_out + (size_t)l * DM * DM; K = DM; N = DM; off = WT_OUT; }
        else if (r < 2112) { r -= 1088; W = p.w1 + (size_t)l * DM * HID; K = DM; N = HID; off = WT_1; }
        else { r -= 2112; W = p.w2 + (size_t)l * HID * DM; K = HID; N = DM; off = WT_2; }
        const int ntn = N / 128, tk = r / ntn, tn = r % ntn;
        transpose_tile(W, K, N, p.wt + (size_t)l * WT_LAYER + off, tk, tn, tile);
    }
}

__device__ void norm_phase(const Params& p, int l, int which  , int M) {
    const int tid = tid_o(), wave = tid >> 6, lane = tid & 63;
    const float* nw = (which ? p.n2w : p.n1w) + l * DM;
    const bool from_input = (l == 0 && which == 0);
    for (int row = bid_o() * 8 + wave; row < M; row += gridDim.x * 8) {
        const bool lat = row < ML; const int r = lat ? (row >> 11) : 8;
        const float* src = lat ? ((from_input ? p.x : p.out) + (size_t)row * DM) : ((from_input ? p.ctx : p.xc) + (size_t)(row - ML) * DM);
        const float* md = p.mod + ((size_t)l * 9 + r) * 12288 + which * 6144;
        f32x4 v[8]; float ss = 0.f;
#pragma unroll
        for (int i = 0; i < 8; ++i) { v[i] = *(const f32x4*)(src + 4 * (lane + 64 * i)); ss += v[i][0] * v[i][0] + v[i][1] * v[i][1] + v[i][2] * v[i][2] + v[i][3] * v[i][3]; }
#pragma unroll
        for (int o = 32; o >= 1; o >>= 1) ss += __shfl_xor(ss, o);
        const float rstd = rsqrtf(ss * (1.0f / DM) + 1e-6f);
        bf16_t* dst = p.h + (size_t)row * DM;
#pragma unroll
        for (int i = 0; i < 8; ++i) { const int col = 4 * (lane + 64 * i);
            const f32x4 w = *(const f32x4*)(nw + col), sh = *(const f32x4*)(md + col), sc = *(const f32x4*)(md + 2048 + col);
            const f32x4 y = v[i] * rstd * w * (1.0f + sc) + sh;
            u32x2 o; o.x = cvt_pk_bf16(y[0], y[1]); o.y = cvt_pk_bf16(y[2], y[3]); *(u32x2*)(dst + col) = o; }
    }
}
__device__ void final_norm_phase(const Params& p) {
    const int tid = tid_o(), wave = tid >> 6, lane = tid & 63;
    for (int row = bid_o() * 8 + wave; row < ML; row += gridDim.x * 8) {
        float* src = p.out + (size_t)row * DM;
        f32x4 v[8]; float ss = 0.f;
#pragma unroll
        for (int i = 0; i < 8; ++i) { v[i] = *(const f32x4*)(src + 4 * (lane + 64 * i)); ss += v[i][0] * v[i][0] + v[i][1] * v[i][1] + v[i][2] * v[i][2] + v[i][3] * v[i][3]; }
#pragma unroll
        for (int o = 32; o >= 1; o >>= 1) ss += __shfl_xor(ss, o);
        const float rstd = rsqrtf(ss * (1.0f / DM) + 1e-6f);
#pragma unroll
        for (int i = 0; i < 8; ++i) { const int col = 4 * (lane + 64 * i); const f32x4 w = *(const f32x4*)(p.fnw + col); *(f32x4*)(src + col) = v[i] * rstd * w; }
    }
}

constexpr int QS = 136, KES = 72;
__device__ void hg_job(const Params& p, int l, int job, LAS unsigned char* lds) {
    const int tid = tid_o(), wid = tid >> 6, lane = tid & 63, fr = lane & 15, fq = lane >> 4;
    LAS bf16_t* QI = (LAS bf16_t*)lds;
    LAS bf16_t* QF = QI + 64 * QS;
    LAS bf16_t* KI = QF + 64 * QS;
    LAS bf16_t* KE = KI + 160 * QS;
    LAS bf16_t* VT = KE + 128 * KES;
    LAS float* PS = (LAS float*)(VT + 32 * KES);
    LAS float* AE = PS + 512;
    const int vs = job & 3, dir = (job >> 2) & 1, hh = (job >> 3) & 3, b = job >> 5;
    const int d = tid & 127, I = tid >> 7;
    const int Iw = wid >> 1, vt = wid & 1;
    float lb = 0.f;
    if (l == 1) { const float l0 = p.lb_logits[dir * 512 + hh * 128 + d], l1 = p.lb_logits[1024 + dir * 512 + hh * 128 + d]; lb = 1.0f / (1.0f + __expf(l0 - l1)); }
    const float omlb = 1.0f - lb;
    const bf16_t* P = p.big;
    float* ohg = (float*)p.h + (size_t)dir * MT * 512;
    f32x4 S[8];
#pragma unroll
    for (int m = 0; m < 8; ++m) S[m] = (f32x4){0.f, 0.f, 0.f, 0.f};
    const int koff = 16 * ((Iw * (Iw + 1)) >> 1);

    for (int step = 0; step < 36; ++step) {
        int base; { if (step < 4) { const int ci = dir ? 3 - step : step; base = ML + b * CT + ci * 64; } else { const int cn = step - 4; const int ci = dir ? 31 - cn : cn; base = b * TL + ci * 64; } }
        const bool skip_out = (l == 1 && step < 4);
        float lf[16], qv[16], kv[16];
#pragma unroll
        for (int i = 0; i < 16; ++i) {
            const int tau = 16 * I + i; const size_t row = (size_t)(base + (dir ? 63 - tau : tau));
            const float x = bf2f(P[row * NIN + C_HF + dir * 512 + hh * 128 + d]);
            const float q = bf2f(P[row * NIN + C_HQ + hh * 128 + d]);
            const float e = __expf(-fabsf(x));
            const float ls = fminf(x, 0.f) - __logf(1.0f + e);
            const float sig = (x >= 0.f ? 1.0f : e) / (1.0f + e);
            lf[i] = (lb > 0.f) ? __logf(lb + omlb * sig) : ls;
            kv[i] = omlb * ((x >= 0.f ? e : 1.0f) / (1.0f + e));
            qv[i] = silu_f(q) * 0.08838834764831845f;
        }
        float run = 0.f;
#pragma unroll
        for (int i = 0; i < 16; ++i) { run += lf[i]; lf[i] = run; }
        PS[I * 128 + d] = run;
        __syncthreads();
        float rr[4]; rr[0] = 0.f; rr[1] = PS[d]; rr[2] = rr[1] + PS[128 + d]; rr[3] = rr[2] + PS[256 + d];
        const float bend = rr[3] + PS[384 + d];
        const float rI = rr[I];
#pragma unroll
        for (int i = 0; i < 16; ++i) {
            const int tau = 16 * I + i; const float bt = rI + lf[i];
            QI[tau * QS + d] = f2bf(qv[i] * __expf(lf[i]));
            QF[tau * QS + d] = f2bf(qv[i] * __expf(bt));
            KE[d * KES + tau] = f2bf(kv[i] * __expf(bend - bt));
#pragma unroll
            for (int Ip = 0; Ip < 4; ++Ip) if (Ip >= I) KI[(16 * ((Ip * (Ip + 1)) >> 1) + tau) * QS + d] = f2bf(kv[i] * __expf(fminf(rr[Ip] - bt, 80.f)));
        }
        if (I == 0) AE[d] = __expf(bend);
        { const int tau = tid >> 3, v4 = tid & 7; const size_t row = (size_t)(base + (dir ? 63 - tau : tau));
          const u32x2 w = *(const u32x2*)(P + row * NIN + C_HI + hh * 128 + vs * 32 + v4 * 4);
          VT[(v4 * 4 + 0) * KES + tau] = (bf16_t)(w.x & 0xffffu); VT[(v4 * 4 + 1) * KES + tau] = (bf16_t)(w.x >> 16);
          VT[(v4 * 4 + 2) * KES + tau] = (bf16_t)(w.y & 0xffffu); VT[(v4 * 4 + 3) * KES + tau] = (bf16_t)(w.y >> 16); }
        __syncthreads();
        if (!skip_out) {
            bf16x8 qb[4];
#pragma unroll
            for (int ks = 0; ks < 4; ++ks) qb[ks] = *(const LAS bf16x8*)(QI + (16 * Iw + fr) * QS + 32 * ks + 8 * fq);
            f32x4 at[4];
#pragma unroll
            for (int J = 0; J < 4; ++J) {
                at[J] = (f32x4){0.f, 0.f, 0.f, 0.f};
                if (J <= Iw) {
#pragma unroll
                    for (int ks = 0; ks < 4; ++ks) { const bf16x8 a = *(const LAS bf16x8*)(KI + (koff + 16 * J + fr) * QS + 32 * ks + 8 * fq); at[J] = __builtin_amdgcn_mfma_f32_16x16x32_bf16(a, qb[ks], at[J], 0, 0, 0); }
                    if (J == Iw) {
#pragma unroll
                        for (int r = 0; r < 4; ++r) if (4 * fq + r > fr) at[J][r] = 0.f; }
                }
            }
            f32x4 oacc = (f32x4){0.f, 0.f, 0.f, 0.f};
#pragma unroll
            for (int kp = 0; kp < 2; ++kp) {
                u32x4 aw; aw.x = cvt_pk_bf16(at[2 * kp][0], at[2 * kp][1]); aw.y = cvt_pk_bf16(at[2 * kp][2], at[2 * kp][3]); aw.z = cvt_pk_bf16(at[2 * kp + 1][0], at[2 * kp + 1][1]); aw.w = cvt_pk_bf16(at[2 * kp + 1][2], at[2 * kp + 1][3]);
                const u32x2 b0 = *(const LAS u32x2*)(VT + (vt * 16 + fr) * KES + 32 * kp + 4 * fq), b1 = *(const LAS u32x2*)(VT + (vt * 16 + fr) * KES + 32 * kp + 16 + 4 * fq);
                u32x4 bw; bw.x = b0.x; bw.y = b0.y; bw.z = b1.x; bw.w = b1.y;
                oacc = __builtin_amdgcn_mfma_f32_16x16x32_bf16(__builtin_bit_cast(bf16x8, aw), __builtin_bit_cast(bf16x8, bw), oacc, 0, 0, 0);
            }
#pragma unroll
            for (int ks = 0; ks < 4; ++ks) {
                const u32x2 a0 = *(const LAS u32x2*)(QF + (16 * Iw + fr) * QS + 32 * ks + 4 * fq), a1 = *(const LAS u32x2*)(QF + (16 * Iw + fr) * QS + 32 * ks + 16 + 4 * fq);
                u32x4 aw; aw.x = a0.x; aw.y = a0.y; aw.z = a1.x; aw.w = a1.y;
                u32x4 bw; bw.x = cvt_pk_bf16(S[2 * ks][0], S[2 * ks][1]); bw.y = cvt_pk_bf16(S[2 * ks][2], S[2 * ks][3]); bw.z = cvt_pk_bf16(S[2 * ks + 1][0], S[2 * ks + 1][1]); bw.w = cvt_pk_bf16(S[2 * ks + 1][2], S[2 * ks + 1][3]);
                oacc = __builtin_amdgcn_mfma_f32_16x16x32_bf16(__builtin_bit_cast(bf16x8, aw), __builtin_bit_cast(bf16x8, bw), oacc, 0, 0, 0);
            }
#pragma unroll
            for (int r = 0; r < 4; ++r) { const int tau = 16 * Iw + 4 * fq + r; const size_t row = (size_t)(base + (dir ? 63 - tau : tau));
                ohg[row * 512 + hh * 128 + vs * 32 + vt * 16 + fr] = oacc[r]; }
        }
#pragma unroll
        for (int m = 0; m < 8; ++m) {
            const f32x4 ae = *(const LAS f32x4*)(AE + 16 * m + 4 * fq);
            S[m] *= ae;
#pragma unroll
            for (int ks = 0; ks < 2; ++ks) {
                const bf16x8 a = *(const LAS bf16x8*)(KE + (16 * m + fr) * KES + 32 * ks + 8 * fq);
                const bf16x8 bv = *(const LAS bf16x8*)(VT + (vt * 16 + fr) * KES + 32 * ks + 8 * fq);
                S[m] = __builtin_amdgcn_mfma_f32_16x16x32_bf16(a, bv, S[m], 0, 0, 0);
            }
        }
        __syncthreads();
    }
}

constexpr int VS = 72;
__device__ void na_item(const Params& p, int l, int item, LAS unsigned char* lds) {
    const int tid = tid_o(), wid = tid >> 6, lane = tid & 63, fr = lane & 15, fq = lane >> 4;
    LAS bf16_t* VTb = (LAS bf16_t*)lds;
    LAS float* RPB = (LAS float*)(lds + 2 * 128 * VS * 2);
    const bf16_t* P = p.big;
    const float LOG2E = 1.4426950408889634f;
    const bool is_lat = item < 1024;
    int b, hh, rp = 0, half = 0;
    if (is_lat) { rp = item & 15; hh = (item >> 4) & 7; b = item >> 7; } else { const int it = item - 1024; half = it & 1; hh = (it >> 1) & 7; b = it >> 4; }
    int r = 0, j = 0, r0w = 0, qtok0;
    if (is_lat) { r = 2 * rp + (wid >> 2); j = wid & 3; r0w = min(max(r - 4, 0), 24); qtok0 = b * TL + r * 64 + 16 * j; }
    else qtok0 = ML + b * CT + half * 128 + 16 * wid;
    const int r0a = min(max(2 * rp - 4, 0), 24), r0b = min(max(2 * rp + 1 - 4, 0), 24);
    const int nlat = is_lat ? (r0b + 8 - r0a) : 0, nst = nlat + 4;
    const int kst = (j == 0) ? 0 : (j == 1) ? 8 : (j == 2) ? 24 : 32;
    if (is_lat) { const float* rp_src = p.rpb + ((size_t)l * 8 + hh) * 465; for (int i = tid; i < 465; i += 512) RPB[i] = rp_src[i] * LOG2E; }
    bf16x8 qb[4];
#pragma unroll
    for (int ks = 0; ks < 4; ++ks) qb[ks] = *(const bf16x8*)(P + (size_t)(qtok0 + fr) * NIN + C_NAQ + hh * 128 + 32 * ks + 8 * fq);
    float m_run = -INFINITY, l_run = 0.f;
    f32x4 O[8];
#pragma unroll
    for (int m = 0; m < 8; ++m) O[m] = (f32x4){0.f, 0.f, 0.f, 0.f};
    const float sc2 = 0.08838834764831845f * LOG2E;
    const int qc = 16 * j + fr, wst = min(max(qc - 8, 0), 48);

    for (int st = 0; st < nst; ++st) {
        const bool lat_st = st < nlat;
        const int rk = r0a + st;
        const int ktok0 = lat_st ? (b * TL + rk * 64) : (ML + b * CT + 64 * (st - nlat));
        LAS bf16_t* VT = VTb + (st & 1) * 128 * VS;
        { const int key = tid >> 3, dc = tid & 7; const bf16_t* src = P + (size_t)(ktok0 + key) * NIN + C_NAV + hh * 128 + 16 * dc;
          const u32x4 w0 = *(const u32x4*)src, w1 = *(const u32x4*)(src + 8);
          LAS bf16_t* dst = VT + (16 * dc) * VS + key;
          dst[0 * VS] = (bf16_t)(w0.x & 0xffffu); dst[1 * VS] = (bf16_t)(w0.x >> 16); dst[2 * VS] = (bf16_t)(w0.y & 0xffffu); dst[3 * VS] = (bf16_t)(w0.y >> 16);
          dst[4 * VS] = (bf16_t)(w0.z & 0xffffu); dst[5 * VS] = (bf16_t)(w0.z >> 16); dst[6 * VS] = (bf16_t)(w0.w & 0xffffu); dst[7 * VS] = (bf16_t)(w0.w >> 16);
          dst[8 * VS] = (bf16_t)(w1.x & 0xffffu); dst[9 * VS] = (bf16_t)(w1.x >> 16); dst[10 * VS] = (bf16_t)(w1.y & 0xffffu); dst[11 * VS] = (bf16_t)(w1.y >> 16);
          dst[12 * VS] = (bf16_t)(w1.z & 0xffffu); dst[13 * VS] = (bf16_t)(w1.z >> 16); dst[14 * VS] = (bf16_t)(w1.w & 0xffffu); dst[15 * VS] = (bf16_t)(w1.w >> 16); }
        __syncthreads();
        const bool active = lat_st ? (rk >= r0w && rk < r0w + 8) : true;
        if (active) {
            const int nsub = lat_st ? 1 : 2;
            for (int sub = 0; sub < nsub; ++sub) {
                const int k0 = lat_st ? kst : 32 * sub;
                f32x4 sa[2];
#pragma unroll
                for (int a = 0; a < 2; ++a) {
                    sa[a] = (f32x4){0.f, 0.f, 0.f, 0.f};
                    const bf16_t* kp = P + (size_t)(ktok0 + k0 + 16 * a + fr) * NIN + C_NAK + hh * 128 + 8 * fq;
#pragma unroll
                    for (int ks = 0; ks < 4; ++ks) { const bf16x8 kf = *(const bf16x8*)(kp + 32 * ks); sa[a] = __builtin_amdgcn_mfma_f32_16x16x32_bf16(kf, qb[ks], sa[a], 0, 0, 0); }
                }
                float s2[8];
#pragma unroll
                for (int a = 0; a < 2; ++a)
#pragma unroll
                    for (int rg = 0; rg < 4; ++rg) {
                        float v = sa[a][rg] * sc2;
                        if (lat_st) { const int kc = k0 + 16 * a + 4 * fq + rg; const bool valid = (kc >= wst) && (kc < wst + 16);
                            const int dcol = min(max(kc - qc, -15), 15) + 15; const int drow = rk - r + 7;
                            v = valid ? v + RPB[drow * 31 + dcol] : -INFINITY; }
                        s2[a * 4 + rg] = v;
                    }
                float mx = s2[0];
#pragma unroll
                for (int i = 1; i < 8; ++i) mx = fmaxf(mx, s2[i]);
                mx = fmaxf(mx, __shfl_xor(mx, 16)); mx = fmaxf(mx, __shfl_xor(mx, 32));
                const float m_new = fmaxf(m_run, mx);
                const float alpha = exp2f(m_run - m_new);
                float ps = 0.f; float pe[8];
#pragma unroll
                for (int i = 0; i < 8; ++i) { pe[i] = exp2f(s2[i] - m_new); ps += pe[i]; }
                l_run = l_run * alpha + ps; m_run = m_new;
                u32x4 pw; pw.x = cvt_pk_bf16(pe[0], pe[1]); pw.y = cvt_pk_bf16(pe[2], pe[3]); pw.z = cvt_pk_bf16(pe[4], pe[5]); pw.w = cvt_pk_bf16(pe[6], pe[7]);
                const bf16x8 pb = __builtin_bit_cast(bf16x8, pw);
#pragma unroll
                for (int m = 0; m < 8; ++m) {
                    const u32x2 a0 = *(const LAS u32x2*)(VT + (16 * m + fr) * VS + k0 + 4 * fq), a1 = *(const LAS u32x2*)(VT + (16 * m + fr) * VS + k0 + 16 + 4 * fq);
                    u32x4 aw; aw.x = a0.x; aw.y = a0.y; aw.z = a1.x; aw.w = a1.y;
                    O[m] *= alpha;
                    O[m] = __builtin_amdgcn_mfma_f32_16x16x32_bf16(__builtin_bit_cast(bf16x8, aw), pb, O[m], 0, 0, 0);
                }
            }
        }
    }
    l_run += __shfl_xor(l_run, 16); l_run += __shfl_xor(l_run, 32);
    const float inv = 1.0f / l_run;
    bf16_t* dst = p.mix + (size_t)(qtok0 + fr) * DM + hh * 128 + 4 * fq;
#pragma unroll
    for (int m = 0; m < 8; ++m) { u32x2 o; o.x = cvt_pk_bf16(O[m][0] * inv, O[m][1] * inv); o.y = cvt_pk_bf16(O[m][2] * inv, O[m][3] * inv); *(u32x2*)(dst + 16 * m) = o; }
    __syncthreads();
}

__device__ void gm_item(const Params& p, int l, int item, LAS unsigned char* lds) {
    const int tid = tid_o(), wid = tid >> 6, lane = tid & 63, fr = lane & 15, fq = lane >> 4;
    LAS bf16_t* VNT = (LAS bf16_t*)lds;
    LAS bf16_t* WS = VNT + 128 * QS;
    const bf16_t* P = p.big;
    const int g = item & 3, row0 = (item >> 2) * 128;
    {
        const int q = tid >> 2, part = tid & 3;
        const bf16_t* src = P + (size_t)(row0 + q) * NIN + C_GV + g * 128 + 32 * part;
        float vf[32];
#pragma unroll
        for (int i = 0; i < 4; ++i) { const u32x4 w = *(const u32x4*)(src + 8 * i);
            vf[8 * i + 0] = gelu_tanh(bflo(w.x)); vf[8 * i + 1] = gelu_tanh(bfhi(w.x)); vf[8 * i + 2] = gelu_tanh(bflo(w.y)); vf[8 * i + 3] = gelu_tanh(bfhi(w.y));
            vf[8 * i + 4] = gelu_tanh(bflo(w.z)); vf[8 * i + 5] = gelu_tanh(bfhi(w.z)); vf[8 * i + 6] = gelu_tanh(bflo(w.w)); vf[8 * i + 7] = gelu_tanh(bfhi(w.w)); }
        float s = 0.f;
#pragma unroll
        for (int i = 0; i < 32; ++i) s += vf[i];
        s += __shfl_xor(s, 1); s += __shfl_xor(s, 2);
        const float mu = s * (1.0f / 128.0f);
        float qq = 0.f;
#pragma unroll
        for (int i = 0; i < 32; ++i) { const float dlt = vf[i] - mu; qq += dlt * dlt; }
        qq += __shfl_xor(qq, 1); qq += __shfl_xor(qq, 2);
        const float rstd = rsqrtf(qq * (1.0f / 128.0f) + 1e-6f);
        const float* lw = p.gm_lnw + l * 512 + g * 128 + 32 * part;
#pragma unroll
        for (int i = 0; i < 32; ++i) VNT[(32 * part + i) * QS + q] = f2bf((vf[i] - mu) * rstd * lw[i]);
        const float* wsrc = p.gm_ws + (((size_t)l * 4 + g) * 128 + q) * 128 + 32 * part;
#pragma unroll
        for (int i = 0; i < 4; ++i) { const f32x4 a = *(const f32x4*)(wsrc + 8 * i), c = *(const f32x4*)(wsrc + 8 * i + 4);
            u32x4 w; w.x = cvt_pk_bf16(a[0], a[1]); w.y = cvt_pk_bf16(a[2], a[3]); w.z = cvt_pk_bf16(c[0], c[1]); w.w = cvt_pk_bf16(c[2], c[3]);
            *(LAS u32x4*)(WS + q * QS + 32 * part + 8 * i) = w; }
    }
    __syncthreads();
    {
        bf16x8 bfr[4];
#pragma unroll
        for (int ks = 0; ks < 4; ++ks) bfr[ks] = *(const LAS bf16x8*)(WS + (16 * wid + fr) * QS + 32 * ks + 8 * fq);
        const int pr = 16 * wid + fr;
        const float bsv = p.gm_bs[(l * 4 + g) * 128 + pr];
        const bf16_t* usrc = P + (size_t)(row0 + pr) * NIN + C_GU + g * 128 + 4 * fq;
        bf16_t* dst = p.mix + (size_t)(row0 + pr) * DM + 1536 + g * 128 + 4 * fq;
#pragma unroll
        for (int m = 0; m < 8; ++m) {
            f32x4 acc = (f32x4){0.f, 0.f, 0.f, 0.f};
#pragma unroll
            for (int ks = 0; ks < 4; ++ks) { const bf16x8 a = *(const LAS bf16x8*)(VNT + (16 * m + fr) * QS + 32 * ks + 8 * fq); acc = __builtin_amdgcn_mfma_f32_16x16x32_bf16(a, bfr[ks], acc, 0, 0, 0); }
            const u32x2 uw = *(const u32x2*)(usrc + 16 * m);
            const float o0 = gelu_tanh(bflo(uw.x)) * (acc[0] + bsv), o1 = gelu_tanh(bfhi(uw.x)) * (acc[1] + bsv), o2 = gelu_tanh(bflo(uw.y)) * (acc[2] + bsv), o3 = gelu_tanh(bfhi(uw.y)) * (acc[3] + bsv);
            u32x2 o; o.x = cvt_pk_bf16(o0, o1); o.y = cvt_pk_bf16(o2, o3); *(u32x2*)(dst + 16 * m) = o;
        }
    }
    __syncthreads();
}

__device__ void gatenorm_phase(const Params& p, int l, int M) {
    const int tid = tid_o(), wave = tid >> 6, lane = tid & 63;
    const float* o0 = (const float*)p.h; const float* o1 = o0 + (size_t)MT * 512;
    const float* nw = p.hg_nw + l * 128 + 8 * (lane & 15);
    const f32x4 w0 = *(const f32x4*)nw, w1 = *(const f32x4*)(nw + 4);
    for (int row = bid_o() * 8 + wave; row < M; row += gridDim.x * 8) {
        const size_t off = (size_t)row * 512 + 8 * lane;
        f32x4 a0 = *(const f32x4*)(o0 + off), a1 = *(const f32x4*)(o0 + off + 4);
        const f32x4 c0 = *(const f32x4*)(o1 + off), c1 = *(const f32x4*)(o1 + off + 4);
        a0 += c0; a1 += c1;
        float ss = a0[0] * a0[0] + a0[1] * a0[1] + a0[2] * a0[2] + a0[3] * a0[3] + a1[0] * a1[0] + a1[1] * a1[1] + a1[2] * a1[2] + a1[3] * a1[3];
        ss += __shfl_xor(ss, 1); ss += __shfl_xor(ss, 2); ss += __shfl_xor(ss, 4); ss += __shfl_xor(ss, 8);
        const float rstd = rsqrtf(ss * (1.0f / 128.0f) + 1e-6f);
        const u32x4 gw = *(const u32x4*)(p.big + (size_t)row * NIN + C_HG + 8 * lane);
        const float g0 = silu_f(bflo(gw.x)), g1 = silu_f(bfhi(gw.x)), g2 = silu_f(bflo(gw.y)), g3 = silu_f(bfhi(gw.y)), g4 = silu_f(bflo(gw.z)), g5 = silu_f(bfhi(gw.z)), g6 = silu_f(bflo(gw.w)), g7 = silu_f(bfhi(gw.w));
        u32x4 o; o.x = cvt_pk_bf16(a0[0] * rstd * w0[0] * g0, a0[1] * rstd * w0[1] * g1); o.y = cvt_pk_bf16(a0[2] * rstd * w0[2] * g2, a0[3] * rstd * w0[3] * g3);
        o.z = cvt_pk_bf16(a1[0] * rstd * w1[0] * g4, a1[1] * rstd * w1[1] * g5); o.w = cvt_pk_bf16(a1[2] * rstd * w1[2] * g6, a1[3] * rstd * w1[3] * g7);
        *(u32x4*)(p.mix + (size_t)row * DM + 1024 + 8 * lane) = o;
    }
}

__device__ void mixer_phase(const Params& p, int l, LAS unsigned char* lds) {
    for (int job = bid_o(); job < 256; job += gridDim.x) hg_job(p, l, job, lds);
    const int n_na = (l == 0) ? 1024 + 128 : 1024;
    for (int it = bid_o(); it < n_na; it += gridDim.x) na_item(p, l, it, lds);
    const int n_gm = (l == 0) ? 576 : 512;
    for (int it = bid_o(); it < n_gm; it += gridDim.x) gm_item(p, l, it, lds);
}

__device__ __forceinline__ void run_phase(const Params& p, int ph, LAS unsigned char* lds) {
    if (ph == 0) { prepass(p, lds); return; }
    if (ph == NPHASE - 1) { final_norm_phase(p); return; }
    const int l = (ph - 1) >> 3, s = (ph - 1) & 7;
    const int Mx = (l == 0) ? MT : ML;
    const bf16_t* wt = p.wt + (size_t)l * WT_LAYER;
    const float* modl = p.mod + (size_t)l * 9 * 12288;
    switch (s) {
    case 0: norm_phase(p, l, 0, MT); break;
    case 1: { pg8::EpiBf16<0> E; E.O = p.big; E.ldc = NIN; run_gemm(lds, p.h, wt + WT_IN, MT, NIN, DM, E); } break;
    case 2: mixer_phase(p, l, lds); break;
    case 3: gatenorm_phase(p, l, Mx); break;
    case 4: { pg8::EpiRes E; E.src_lat = (l == 0) ? p.x : p.out; E.src_ctx = (l == 0) ? p.ctx : p.xc; E.dst_lat = p.out; E.dst_ctx = p.xc; E.gate = modl + 4096;
              run_gemm(lds, p.mix, wt + WT_OUT, Mx, DM, DM, E); } break;
    case 5: norm_phase(p, l, 1, Mx); break;
    case 6: { pg8::EpiBf16<1> E; E.O = p.big; E.ldc = HID; run_gemm(lds, p.h, wt + WT_1, Mx, HID, DM, E); } break;
    case 7: { pg8::EpiRes E; E.src_lat = p.out; E.src_ctx = p.xc; E.dst_lat = p.out; E.dst_ctx = p.xc; E.gate = modl + 10240;
              run_gemm(lds, p.big, wt + WT_2, Mx, DM, HID, E); } break;
    }
}

__global__ void __launch_bounds__(512, 2) mega(Params p, int ph_lo, int ph_hi) {
    extern __shared__ __attribute__((aligned(16))) unsigned char shm[];
    LAS unsigned char* lds = (LAS unsigned char*)shm;
    for (int ph = ph_lo; ph < ph_hi; ++ph) {
        run_phase(p, ph, lds);
        if (ph + 1 < ph_hi) { __threadfence(); cg::this_grid().sync(); }
    }
}

extern "C" void kernel_launch(void* const* d_in, const int* in_sizes, int n_in, void* d_out, int out_size, void* d_ws, size_t ws_size, hipStream_t stream) {
    static int grid_blocks = 0;
    if (!grid_blocks) {
        hipFuncSetAttribute((const void*)mega, hipFuncAttributeMaxDynamicSharedMemorySize, LDS_BYTES);
        int dev = 0, cus = 0, per_cu = 0;
        hipGetDevice(&dev);
        hipDeviceGetAttribute(&cus, hipDeviceAttributeMultiprocessorCount, dev);
        hipOccupancyMaxActiveBlocksPerMultiprocessor(&per_cu, mega, 512, LDS_BYTES);
        if (per_cu < 1) per_cu = 1;
        grid_blocks = cus * 1;
        if (grid_blocks > 256) grid_blocks = 256;
    }
    Params p{};
    p.x = (const float*)d_in[0]; p.c = (const float*)d_in[1]; p.ctx = (const float*)d_in[2]; p.c_ctx = (const float*)d_in[3];
    p.ada_w = (const float*)d_in[4]; p.ada_b = (const float*)d_in[5]; p.n1w = (const float*)d_in[6]; p.n2w = (const float*)d_in[7];
    p.w_in = (const float*)d_in[8]; p.rpb = (const float*)d_in[9]; p.lb_logits = (const float*)d_in[10]; p.hg_nw = (const float*)d_in[11];
    p.gm_lnw = (const float*)d_in[12]; p.gm_ws = (const float*)d_in[13]; p.gm_bs = (const float*)d_in[14]; p.w_out = (const float*)d_in[15];
    p.w1 = (const float*)d_in[16]; p.w2 = (const float*)d_in[17]; p.fnw = (const float*)d_in[18];
    p.out = (float*)d_out;
    char* ws = (char*)d_ws; size_t o = 0;
    auto take = [&](size_t bytes) { char* r = ws + o; o += (bytes + 255) & ~(size_t)255; return r; };
    p.wt = (bf16_t*)take(2 * WT_LAYER * 2);
    p.xc = (float*)take((size_t)MC * DM * 4);
    p.h = (bf16_t*)take((size_t)MT * DM * 2);
    p.mix = (bf16_t*)take((size_t)MT * DM * 2);
    p.big = (bf16_t*)take((size_t)MT * HID * 2);
    p.mod = (float*)take((size_t)2 * 9 * 12288 * 4);
    if (o > ws_size) { fprintf(stderr, "workspace too small: need %zu have %zu\n", o, ws_size); return; }
#if ONE_LAUNCH
    int lo = 0, hi = NPHASE;
    void* args[] = {&p, &lo, &hi};
    hipError_t e = hipLaunchCooperativeKernel((const void*)mega, dim3(grid_blocks), dim3(512), args, LDS_BYTES, stream);
    if (e != hipSuccess) fprintf(stderr, "cooperative launch failed: %s (grid %d)\n", hipGetErrorString(e), grid_blocks);
#else
    for (int ph = 0; ph < NPHASE; ++ph) hipLaunchKernelGGL(mega, dim3(grid_blocks), dim3(512), LDS_BYTES, stream, p, ph, ph + 1);
#endif
}
```

```cpp
#include <hip/hip_runtime.h>
#include <hip/hip_cooperative_groups.h>
#include <cstdio>
namespace cg = cooperative_groups;

#ifndef ONE_LAUNCH
#define ONE_LAUNCH 1
#endif

#define LAS __attribute__((address_space(3)))
typedef unsigned short bf16_t;
typedef short bf16x8 __attribute__((ext_vector_type(8)));
typedef short s16x4 __attribute__((ext_vector_type(4)));
typedef float f32x4 __attribute__((ext_vector_type(4)));
typedef unsigned u32x4 __attribute__((ext_vector_type(4)));
typedef unsigned u32x2 __attribute__((ext_vector_type(2)));

constexpr int DM = 2048, NB = 8, TL = 2048, CT = 256, ML = NB * TL, MC = NB * CT, MT = ML + MC;
constexpr int NIN = 6656, HID = 8192;
constexpr size_t WT_IN = 0, WT_OUT = (size_t)NIN * DM, WT_1 = WT_OUT + (size_t)DM * DM, WT_2 = WT_1 + (size_t)HID * DM, WT_LAYER = WT_2 + (size_t)DM * HID;
constexpr int LDS_BYTES = 131072 + 64;
constexpr int NPL = 8;
constexpr int NPHASE = 2 + 2 * NPL;
constexpr int C_NAQ = 0, C_NAK = 1024, C_NAV = 2048, C_HQ = 3072, C_HF = 3584, C_HI = 4608, C_HG = 5120, C_GU = 5632, C_GV = 6144;

struct Params {
    const float *x, *c, *ctx, *c_ctx, *ada_w, *ada_b, *n1w, *n2w, *w_in, *rpb, *lb_logits, *hg_nw, *gm_lnw, *gm_ws, *gm_bs, *w_out, *w1, *w2, *fnw;
    float* out;
    float* xc;
    bf16_t* wt;
    bf16_t* h;
    bf16_t* mix;
    bf16_t* big;
    float* mod;
    unsigned* bar;
    bf16_t* ug;
    bf16_t* qfg;
    float* aeg;
    bf16_t* oib;
};
typedef const Params __attribute__((address_space(4)))* KParams;

__device__ __forceinline__ unsigned cvt_pk_bf16(float lo, float hi) { unsigned r; asm("v_cvt_pk_bf16_f32 %0, %1, %2" : "=v"(r) : "v"(lo), "v"(hi)); return r; }
__device__ __forceinline__ float bf2f(bf16_t b) { return __uint_as_float(((unsigned)b) << 16); }
__device__ __forceinline__ float bflo(unsigned w) { return __uint_as_float(w << 16); }
__device__ __forceinline__ float bfhi(unsigned w) { return __uint_as_float(w & 0xffff0000u); }
__device__ __forceinline__ bf16_t f2bf(float f) { return (bf16_t)(cvt_pk_bf16(f, 0.f) & 0xffffu); }
__device__ __forceinline__ void mfma_settle(f32x4& a) { asm volatile("s_nop 7\n\ts_nop 7\n\ts_nop 3" : "+v"(a)); }
__device__ __forceinline__ float rowmax4(float x) {
    auto r = __builtin_amdgcn_permlane16_swap(__float_as_uint(x), __float_as_uint(x), false, false); x = fmaxf(__uint_as_float(r[0]), __uint_as_float(r[1]));
    auto s = __builtin_amdgcn_permlane32_swap(__float_as_uint(x), __float_as_uint(x), false, false); return fmaxf(__uint_as_float(s[0]), __uint_as_float(s[1]));
}
__device__ __forceinline__ float rowsum4(float x) {
    auto r = __builtin_amdgcn_permlane16_swap(__float_as_uint(x), __float_as_uint(x), false, false); x = __uint_as_float(r[0]) + __uint_as_float(r[1]);
    auto s = __builtin_amdgcn_permlane32_swap(__float_as_uint(x), __float_as_uint(x), false, false); return __uint_as_float(s[0]) + __uint_as_float(s[1]);
}
__device__ __forceinline__ void lds_barrier() { asm volatile("s_waitcnt lgkmcnt(0)" ::: "memory"); __builtin_amdgcn_s_barrier(); asm volatile("" ::: "memory"); }
__device__ __forceinline__ int tid_o() { int t = (int)threadIdx.x; asm volatile("" : "+v"(t)); return t; }
__device__ __forceinline__ int bid_o() { int t = (int)blockIdx.x; asm volatile("" : "+s"(t)); return t; }
__device__ __forceinline__ int next_item(unsigned* ctr, volatile LAS unsigned* slot) {
    __syncthreads();
    if (threadIdx.x == 0) *slot = atomicAdd(ctr, 1u);
    __syncthreads();
    return (int)*slot;
}
__device__ __forceinline__ float gelu_tanh(float x) { const float z = 0.7978845608028654f * (x + 0.044715f * x * x * x); return x * __builtin_amdgcn_rcpf(1.0f + __expf(-2.0f * z)); }
__device__ __forceinline__ float silu_f(float x) { return x * __builtin_amdgcn_rcpf(1.0f + __expf(-x)); }

namespace pg8 {
constexpr int BM = 256, BK = 64, HALF = 128, HTB = HALF * BK * 2, STAGE_BYTES = 8 * HTB, NXCD = 8, WGM = 8;
__device__ __forceinline__ int lds_byte(int r, int c) { const int st = (r >> 4) * 2 + (c >> 5), rr = r & 15, cc = c & 31, ob = rr * 64 + cc * 2; return st * 1024 + (ob ^ (((ob >> 9) & 1) << 5)); }
__device__ __forceinline__ void stage_rc(int b, int& R, int& C) { const int st = b / 1024, sb = b % 1024, swz = sb ^ (((sb >> 9) & 1) << 5); R = (st >> 1) * 16 + swz / 64; C = (st & 1) * 32 + (swz % 64) / 2; }
__device__ __forceinline__ int perm32(int rho) { const int n = rho >> 4, i = rho & 15; return 8 * (i >> 2) + 4 * n + (i & 3); }
struct Unit { int pm, pn, ks; };
struct Gemm { const bf16_t* A; const bf16_t* Bt; int M, N, K; int ld; };
struct StaticOrder {
    int nM, nN, nwg, G, c;
    __device__ void init(int M, int N, int G_, int c_) { nM = M / BM; nN = N / BM; nwg = nM * nN; G = G_; c = c_; }
    __device__ bool next(int i, Unit& u) const {
        const long L = (long)i * G + c; if (L >= nwg) return false;
        int wgid = (int)L; { const int q = nwg / NXCD, r = nwg % NXCD, xcd = wgid % NXCD, off = wgid / NXCD; wgid = (xcd < r ? xcd * (q + 1) : r * (q + 1) + (xcd - r) * q) + off; }
        const int nig = WGM * nN, gid = wgid / nig, fm = gid * WGM, gsz = (nM - fm) < WGM ? (nM - fm) : WGM;
        u.pm = fm + ((wgid % nig) % gsz); u.pn = (wgid % nig) / gsz; u.ks = 0; return true;
    }
};

struct InOrder {
    StaticOrder lat; int G, c, ncc, trim;
    __device__ void init(int G_, int c_, int trim_) { lat.init(16384, 6656, G_, c_); G = G_; c = c_; trim = trim_; ncc = trim_ ? 14 : 26; }
    __device__ bool next(int i, Unit& u) const {
        const int L = i * G + c;
        if (L < 1664) return lat.next(i, u);
        const int e = L - 1664; if (e >= 8 * ncc) return false;
        const int cr = e / ncc, ci = e - cr * ncc;
        u.pm = 64 + cr; u.pn = trim ? (ci < 8 ? 4 + ci : 6 + ci) : ci; u.ks = 0; return true;
    }
};
struct SplitOrder {
    int nM, nN, nS, G, c;
    __device__ void init(int M, int N, int nS_, int G_, int c_) { nM = M / BM; nN = N / BM; nS = nS_; G = G_; c = c_; }
    __device__ bool next(int i, Unit& u) const {
        const int L = i * G + c; if (L >= nM * nN * nS) return false;
        u.ks = L / (nM * nN); const int r = L - u.ks * (nM * nN); u.pn = r / nM; u.pm = r - u.pn * nM; return true;
    }
};
template <int ACT  > struct EpiBf16 {
    static constexpr bool PERM = true;
    bf16_t* O; int ldc;
    __device__ __forceinline__ void operator()(const f32x4 (&acc)[2][2][4][2], const Unit& u, int wr, int wc, int fr, int fq) const {
        const int row0 = u.pm * BM + wr * 64 + fr, col0 = u.pn * BM + wc * 32 + 8 * fq;
#pragma unroll
        for (int ai = 0; ai < 2; ++ai)
#pragma unroll
            for (int m = 0; m < 4; ++m) { bf16_t* rowp = O + (size_t)(row0 + ai * HALF + m * 16) * ldc + col0;
#pragma unroll
                for (int bj = 0; bj < 2; ++bj) { f32x4 v0 = acc[ai][bj][m][0], v1 = acc[ai][bj][m][1];
                    if (ACT == 1) {
#pragma unroll
                        for (int j = 0; j < 4; ++j) { float a = fmaxf(v0[j], 0.f), b = fmaxf(v1[j], 0.f); v0[j] = a * a; v1[j] = b * b; } }
                    u32x4 w; w.x = cvt_pk_bf16(v0[0], v0[1]); w.y = cvt_pk_bf16(v0[2], v0[3]); w.z = cvt_pk_bf16(v1[0], v1[1]); w.w = cvt_pk_bf16(v1[2], v1[3]);
                    *(u32x4*)(rowp + bj * HALF) = w; } }
    }
};
struct EpiRes {
    static constexpr bool PERM = false;
    const float* src_lat; const float* src_ctx; float* dst_lat; float* dst_ctx; const float* gate;
    __device__ __forceinline__ void operator()(const f32x4 (&acc)[2][2][4][2], const Unit& u, int wr, int wc, int fr, int fq) const {
        const bool lat = u.pm < 64; const int r = lat ? (u.pm >> 3) : 8;
        const float* s = lat ? src_lat : src_ctx; float* d = lat ? dst_lat : dst_ctx;
        const int row0 = (lat ? u.pm : u.pm - 64) * BM + wr * 64 + fr, col0 = u.pn * BM + wc * 32 + 4 * fq;
        const float* g = gate + (size_t)r * 12288 + col0;
        f32x4 gv[2][2];
#pragma unroll
        for (int bj = 0; bj < 2; ++bj)
#pragma unroll
            for (int n = 0; n < 2; ++n) gv[bj][n] = *(const f32x4*)(g + bj * HALF + n * 16);
        f32x4 xc[2][2], xn[2][2];
#pragma unroll
        for (int bj = 0; bj < 2; ++bj)
#pragma unroll
            for (int n = 0; n < 2; ++n) xc[bj][n] = *(const f32x4*)(s + (size_t)row0 * DM + col0 + bj * HALF + n * 16);
#pragma unroll
        for (int gi = 0; gi < 8; ++gi) { const int ai = gi >> 2, m = gi & 3; const size_t off = (size_t)(row0 + ai * HALF + m * 16) * DM + col0;
            if (gi + 1 < 8) { const int ai2 = (gi + 1) >> 2, m2 = (gi + 1) & 3; const size_t off2 = (size_t)(row0 + ai2 * HALF + m2 * 16) * DM + col0;
#pragma unroll
                for (int bj = 0; bj < 2; ++bj)
#pragma unroll
                    for (int n = 0; n < 2; ++n) xn[bj][n] = *(const f32x4*)(s + off2 + bj * HALF + n * 16); }
#pragma unroll
            for (int bj = 0; bj < 2; ++bj)
#pragma unroll
                for (int n = 0; n < 2; ++n) *(f32x4*)(d + off + bj * HALF + n * 16) = xc[bj][n] + gv[bj][n] * acc[ai][bj][m][n];
#pragma unroll
            for (int bj = 0; bj < 2; ++bj)
#pragma unroll
                for (int n = 0; n < 2; ++n) xc[bj][n] = xn[bj][n]; }
    }
};

struct EpiPart {
    static constexpr bool PERM = false;
    float* part; int Mp, ldc;
    __device__ __forceinline__ void operator()(const f32x4 (&acc)[2][2][4][2], const Unit& u, int wr, int wc, int fr, int fq) const {
        const int row0 = u.pm * BM + wr * 64 + fr, col0 = u.pn * BM + wc * 32 + 4 * fq;
        float* base = part + (size_t)u.ks * Mp * ldc;
#pragma unroll
        for (int ai = 0; ai < 2; ++ai)
#pragma unroll
            for (int m = 0; m < 4; ++m) { float* rowp = base + (size_t)(row0 + ai * HALF + m * 16) * ldc + col0;
#pragma unroll
                for (int bj = 0; bj < 2; ++bj)
#pragma unroll
                    for (int n = 0; n < 2; ++n) *(f32x4*)(rowp + bj * HALF + n * 16) = acc[ai][bj][m][n]; }
    }
};

template <class Epi, class Sched>
__device__ __forceinline__ void gemm_phase(LAS unsigned char* lds, const Gemm g, const Sched& S, const Epi& E) {
    const int tid = tid_o(), wid = __builtin_amdgcn_readfirstlane(tid >> 6), lane = tid & 63, wr = wid >> 2, wc = wid & 3, fr = lane & 15, fq = lane >> 4;
    const int K = g.K, nt = K / BK;
    unsigned voffA[2], voffB[2];
#pragma unroll
    for (int i = 0; i < 2; ++i) { int R, C; stage_rc(tid * 16 + i * 8192, R, C); const int Rb = Epi::PERM ? ((R & ~31) + perm32(R & 31)) : R;
        voffA[i] = (unsigned)(R * g.ld + C) * 2u; voffB[i] = (unsigned)(Rb * g.ld + C) * 2u; }
    const size_t kstep = (size_t)(BK * 2);
    const size_t hstep = (size_t)HALF * g.ld * 2;
    const size_t tstep = 2 * hstep, sstep = (size_t)K * 2;
    const unsigned ldsw = (unsigned)wid * 1024u;
    const int aoff = lds_byte(wr * 64 + fr, fq * 8), boff = lds_byte(wc * 32 + fr, fq * 8);
#define PG8_SA(b, h) (((b) * 2 + (h)) * HTB)
#define PG8_SB(b, h) ((4 + (b) * 2 + (h)) * HTB)
#define PG8_STAGE(bufoff, gbase, voff) do { _Pragma("unroll") for (int _i = 0; _i < 2; ++_i) \
        __builtin_amdgcn_global_load_lds((const unsigned*)((const char*)(gbase) + (voff)[_i]), (LAS unsigned*)(lds + (bufoff) + ldsw + _i * 8192), 16, 0, 0); } while (0)
#define PG8_LDA(dst, b, h) do { _Pragma("unroll") for (int m = 0; m < 4; ++m) _Pragma("unroll") for (int k = 0; k < 2; ++k) dst[m][k] = *(const LAS bf16x8*)(lds + PG8_SA(b, h) + aoff + m * 2048 + k * 1024); } while (0)
#define PG8_LDB(dst, b, h) do { _Pragma("unroll") for (int n = 0; n < 2; ++n) _Pragma("unroll") for (int k = 0; k < 2; ++k) dst[n][k] = *(const LAS bf16x8*)(lds + PG8_SB(b, h) + boff + n * 2048 + k * 1024); } while (0)
#define PG8_MMA(ai, bj, At, Bt) do { __builtin_amdgcn_s_setprio(1); _Pragma("unroll") for (int m = 0; m < 4; ++m) _Pragma("unroll") for (int n = 0; n < 2; ++n) _Pragma("unroll") for (int k = 0; k < 2; ++k) \
        acc[ai][bj][m][n] = __builtin_amdgcn_mfma_f32_16x16x32_bf16(Bt[n][k], At[m][k], acc[ai][bj][m][n], 0, 0, 0); __builtin_amdgcn_s_setprio(0); } while (0)
#define PG8_WAIT_V(n) asm volatile("s_waitcnt vmcnt(" #n ")" ::: "memory")
#define PG8_WAIT_L(n) asm volatile("s_waitcnt lgkmcnt(" #n ")" ::: "memory")
#define PG8_BAR __builtin_amdgcn_s_barrier()
#define PG8_SCHED __builtin_amdgcn_sched_barrier(0)
    Unit cur, nxt; int ui = 0;
    if (!S.next(0, cur)) return;
    f32x4 acc[2][2][4][2];
#pragma unroll
    for (int a = 0; a < 2; ++a)
#pragma unroll
        for (int b = 0; b < 2; ++b)
#pragma unroll
            for (int m = 0; m < 4; ++m)
#pragma unroll
                for (int n = 0; n < 2; ++n) acc[a][b][m][n] = (f32x4){0.f, 0.f, 0.f, 0.f};
    bf16x8 At[4][2], B0[2][2], B1[2][2];
    const char* cA = (const char*)g.A + (size_t)cur.pm * tstep + (size_t)cur.ks * sstep; const char* cB = (const char*)g.Bt + (size_t)cur.pn * tstep + (size_t)cur.ks * sstep;
    PG8_STAGE(PG8_SB(0, 0), cB, voffB); PG8_STAGE(PG8_SA(0, 0), cA, voffA); PG8_STAGE(PG8_SB(0, 1), cB + hstep, voffB); PG8_STAGE(PG8_SA(0, 1), cA + hstep, voffA);
    if (wr == 1) PG8_BAR;
    PG8_WAIT_V(4); PG8_BAR;
    PG8_STAGE(PG8_SB(1, 0), cB + kstep, voffB); PG8_STAGE(PG8_SA(1, 0), cA + kstep, voffA); PG8_STAGE(PG8_SB(1, 1), cB + hstep + kstep, voffB);
    PG8_WAIT_V(6); PG8_BAR;
    for (;;) {
        const bool has_next = S.next(ui + 1, nxt);
        const char* nA = has_next ? (const char*)g.A + (size_t)nxt.pm * tstep + (size_t)nxt.ks * sstep : cA; const char* nB = has_next ? (const char*)g.Bt + (size_t)nxt.pn * tstep + (size_t)nxt.ks * sstep : cB;
        for (int t = 0; t < nt; t += 2) {
            const bool last = (t == nt - 2);
            const char* a1 = cA + (size_t)(t + 1) * kstep;
            const char* a2 = last ? nA : cA + (size_t)(t + 2) * kstep; const char* b2 = last ? nB : cB + (size_t)(t + 2) * kstep;
            const char* a3 = a2 + kstep; const char* b3 = b2 + kstep;
            PG8_LDB(B0, 0, 0); PG8_SCHED; PG8_LDA(At, 0, 0); PG8_STAGE(PG8_SA(1, 1), a1 + hstep, voffA);
            PG8_WAIT_L(8); PG8_BAR; PG8_WAIT_L(0); PG8_MMA(0, 0, At, B0); PG8_BAR; PG8_SCHED;
            PG8_LDB(B1, 0, 1); PG8_STAGE(PG8_SB(0, 0), b2, voffB);
            PG8_BAR; PG8_WAIT_L(0); PG8_MMA(0, 1, At, B1); PG8_BAR;
            PG8_LDA(At, 0, 1); PG8_STAGE(PG8_SA(0, 0), a2, voffA);
            PG8_BAR; PG8_WAIT_L(0); PG8_MMA(1, 0, At, B0); PG8_BAR; PG8_SCHED;
            PG8_STAGE(PG8_SB(0, 1), b2 + hstep, voffB);
            PG8_WAIT_V(6); PG8_BAR; PG8_MMA(1, 1, At, B1); PG8_BAR;
            PG8_LDB(B0, 1, 0); PG8_SCHED; PG8_LDA(At, 1, 0); PG8_STAGE(PG8_SA(0, 1), a2 + hstep, voffA);
            PG8_WAIT_L(8); PG8_BAR; PG8_WAIT_L(0); PG8_MMA(0, 0, At, B0); PG8_BAR; PG8_SCHED;
            PG8_LDB(B1, 1, 1); PG8_STAGE(PG8_SB(1, 0), b3, voffB);
            PG8_BAR; PG8_WAIT_L(0); PG8_MMA(0, 1, At, B1); PG8_BAR;
            PG8_LDA(At, 1, 1); PG8_STAGE(PG8_SA(1, 0), a3, voffA);
            PG8_BAR; PG8_WAIT_L(0); PG8_MMA(1, 0, At, B0); PG8_BAR; PG8_SCHED;
            PG8_STAGE(PG8_SB(1, 1), b3 + hstep, voffB);
            PG8_WAIT_V(6); PG8_BAR; PG8_MMA(1, 1, At, B1); PG8_BAR;
        }
        E(acc, cur, wr, wc, fr, fq);
        if (!has_next) break;
#pragma unroll
        for (int a = 0; a < 2; ++a)
#pragma unroll
            for (int b = 0; b < 2; ++b)
#pragma unroll
                for (int m = 0; m < 4; ++m)
#pragma unroll
                    for (int n = 0; n < 2; ++n) acc[a][b][m][n] = (f32x4){0.f, 0.f, 0.f, 0.f};
        cur = nxt; cA = nA; cB = nB; ++ui;
    }
    PG8_WAIT_V(0);
    if (wr == 0) PG8_BAR;
    PG8_BAR;
#undef PG8_SA
#undef PG8_SB
#undef PG8_STAGE
#undef PG8_LDA
#undef PG8_LDB
#undef PG8_MMA
#undef PG8_WAIT_V
#undef PG8_WAIT_L
#undef PG8_BAR
#undef PG8_SCHED
}
}

template <class Epi>
__device__ __forceinline__ void run_gemm(LAS unsigned char* lds, const bf16_t* A, const bf16_t* Bt, int M, int N, int K, const Epi& E) {
    pg8::Gemm g; g.A = A; g.Bt = Bt; g.M = M; g.N = N; g.K = K; g.ld = K;
    pg8::StaticOrder S; S.init(M, N, (int)gridDim.x, bid_o());
    pg8::gemm_phase(lds, g, S, E);
    __syncthreads();
}
template <class Epi, class Sched>
__device__ __forceinline__ void run_gemm_s(LAS unsigned char* lds, const bf16_t* A, const bf16_t* Bt, int M, int N, int K, int ld, const Sched& S, const Epi& E) {
    pg8::Gemm g; g.A = A; g.Bt = Bt; g.M = M; g.N = N; g.K = K; g.ld = ld;
    pg8::gemm_phase(lds, g, S, E);
    __syncthreads();
}

__device__ void ada_prep(KParams p, LAS unsigned char* lds) {
    LAS float* sc = (LAS float*)lds;
    const int tid = tid_o();
    for (int i = tid; i < 9 * 2048; i += 512) { const int r = i >> 11, d = i & 2047; const float v = r < 8 ? p->c[r * 2048 + d] : p->c_ctx[d]; sc[i] = silu_f(v); }
    __syncthreads();
}
__device__ void ada_item(KParams p, int item, LAS unsigned char* lds) {
    LAS float* sc = (LAS float*)lds;
    LAS float* red = sc + 9 * 2048;
    const int tid = tid_o();
    {
        const int l = item / 96, cb = item % 96, tx = tid & 31, ty = tid >> 5;
        const float* W = p->ada_w + (size_t)l * 2048 * 12288 + cb * 128 + tx * 4;
        f32x4 acc[9];
#pragma unroll
        for (int r = 0; r < 9; ++r) acc[r] = (f32x4){0.f, 0.f, 0.f, 0.f};
#pragma unroll 8
        for (int dd = 0; dd < 128; ++dd) { const int d = ty * 128 + dd; const f32x4 w = *(const f32x4*)(W + (size_t)d * 12288);
#pragma unroll
            for (int r = 0; r < 9; ++r) acc[r] += sc[r * 2048 + d] * w; }
#pragma unroll
        for (int r = 0; r < 9; ++r)
#pragma unroll
            for (int j = 0; j < 4; ++j) acc[r][j] += __shfl_xor(acc[r][j], 32);
        if ((tid & 32) == 0) { const int wave = tid >> 6;
#pragma unroll
            for (int r = 0; r < 9; ++r) *(LAS f32x4*)&red[(wave * 9 + r) * 128 + tx * 4] = acc[r]; }
        __syncthreads();
        for (int o = tid; o < 9 * 128; o += 512) { const int r = o >> 7, cc = o & 127; float s = 0.f;
#pragma unroll
            for (int w = 0; w < 8; ++w) s += red[(w * 9 + r) * 128 + cc];
            p->mod[((size_t)l * 9 + r) * 12288 + cb * 128 + cc] = s + p->ada_b[l * 12288 + cb * 128 + cc]; }
        __syncthreads();
    }
}

struct TTile { const float* W; bf16_t* Wt; int K, N, tk, tn; };
__device__ __forceinline__ TTile tile_desc(KParams p, int it) {
    TTile t; const int l = it / 3136; int r = it % 3136; size_t off;
    if (r < 832) { t.W = p->w_in + (size_t)l * DM * NIN; t.K = DM; t.N = NIN; off = WT_IN; }
    else if (r < 1088) { r -= 832; t.W = p->w_out + (size_t)l * DM * DM; t.K = DM; t.N = DM; off = WT_OUT; }
    else if (r < 2112) { r -= 1088; t.W = p->w1 + (size_t)l * DM * HID; t.K = DM; t.N = HID; off = WT_1; }
    else { r -= 2112; t.W = p->w2 + (size_t)l * HID * DM; t.K = HID; t.N = DM; off = WT_2; }
    const int ntn = t.N / 128; t.tk = r / ntn; t.tn = r % ntn; t.Wt = p->wt + (size_t)l * WT_LAYER + off; return t;
}
__device__ __forceinline__ void tile_load(f32x4 (&v)[8], const TTile& t, int tid) {
    const int kr = tid >> 5, n4 = tid & 31;
#pragma unroll
    for (int i = 0; i < 8; ++i) v[i] = *(const f32x4*)(t.W + (size_t)(t.tk * 128 + kr + 16 * i) * t.N + t.tn * 128 + n4 * 4);
}
template <class F>
__device__ __forceinline__ void transpose_tiles(KParams p, LAS unsigned char* lds, int n_it, const F& tile_of) {
    const int tid = tid_o();
    LAS float* tile = (LAS float*)lds;
    if (n_it <= 0) return;
    f32x4 v[8];
    TTile cur = tile_desc(p, tile_of(0));
    tile_load(v, cur, tid);
    for (int it = 0; it < n_it; ++it) {
        { const int kr = tid >> 5, n4 = tid & 31;
#pragma unroll
          for (int i = 0; i < 8; ++i) { LAS float* t = tile + (kr + 16 * i) * 129 + n4 * 4; t[0] = v[i][0]; t[1] = v[i][1]; t[2] = v[i][2]; t[3] = v[i][3]; } }
        TTile nxt = cur;
        if (it + 1 < n_it) { nxt = tile_desc(p, tile_of(it + 1)); tile_load(v, nxt, tid); }
        lds_barrier();
        { const int nr = tid >> 4, k8 = tid & 15;
#pragma unroll
          for (int i = 0; i < 4; ++i) { const int n = nr + 32 * i; float f[8];
#pragma unroll
              for (int j = 0; j < 8; ++j) f[j] = tile[(k8 * 8 + j) * 129 + n];
              u32x4 w; w.x = cvt_pk_bf16(f[0], f[1]); w.y = cvt_pk_bf16(f[2], f[3]); w.z = cvt_pk_bf16(f[4], f[5]); w.w = cvt_pk_bf16(f[6], f[7]);
              *(u32x4*)(cur.Wt + (size_t)(cur.tn * 128 + n) * cur.K + cur.tk * 128 + k8 * 8) = w; } }
        lds_barrier();
        cur = nxt;
    }
}
__device__ void prepass(KParams p, LAS unsigned char* lds) {
    const int tid = tid_o(), bid = bid_o();
    if (bid < 192) { ada_prep(p, lds); ada_item(p, bid, lds); }
    const int n_it = bid < 192 ? 14 : 24;
    auto tile_of = [&](int k) { return k < 14 ? k * 256 + bid : 3584 + (k - 14) * 64 + (bid - 192); };
    int it = 0; const int it_end = n_it;
    transpose_tiles(p, lds, it_end, tile_of);
}

__device__ __forceinline__ const float* norm_src(KParams p, int l, bool from_input, int row) {
    return row < ML ? ((from_input ? p->x : p->out) + (size_t)row * DM) : (((from_input || l == 0) ? p->ctx : p->xc) + (size_t)(row - ML) * DM);
}
__device__ __forceinline__ void norm_phase(KParams p, int l, int which  , int M) {
    const int tid = tid_o(), wave = tid >> 6, lane = tid & 63;
    const float* nw = (which ? p->n2w : p->n1w) + l * DM;
    const bool from_input = (l == 0 && which == 0);
    const int g = bid_o() * 8 + wave, row0 = (g >> 8) * 2048 + (g & 255);
    const bool has_ctx = M > ML;
    f32x4 v[8], vn[8], wsc[8], sh[8];
    auto load_mod = [&](int r) { const float* md = p->mod + ((size_t)l * 9 + r) * 12288 + which * 6144;
#pragma unroll
        for (int i = 0; i < 8; ++i) { const int col = 4 * (lane + 64 * i); sh[i] = *(const f32x4*)(md + col); wsc[i] = *(const f32x4*)(nw + col) * (1.0f + *(const f32x4*)(md + 2048 + col)); } };
    auto finish = [&](int row) {
        float ss = 0.f;
#pragma unroll
        for (int i = 0; i < 8; ++i) ss += v[i][0] * v[i][0] + v[i][1] * v[i][1] + v[i][2] * v[i][2] + v[i][3] * v[i][3];
#pragma unroll
        for (int o = 32; o >= 1; o >>= 1) ss += __shfl_xor(ss, o);
        const float rstd = rsqrtf(ss * (1.0f / DM) + 1e-6f);
        bf16_t* dst = p->h + (size_t)row * DM;
#pragma unroll
        for (int i = 0; i < 8; ++i) { const int col = 4 * (lane + 64 * i);
            const f32x4 y = v[i] * rstd * wsc[i] + sh[i];
            u32x2 o; o.x = cvt_pk_bf16(y[0], y[1]); o.y = cvt_pk_bf16(y[2], y[3]); *(u32x2*)(dst + col) = o; } };
#pragma unroll
    for (int i = 0; i < 8; ++i) v[i] = *(const f32x4*)(norm_src(p, l, from_input, row0) + 4 * (lane + 64 * i));
    load_mod(g >> 8);
    for (int k = 0; k < 8; ++k) {
        const int row = row0 + 256 * k;
        if (k + 1 < 8 || has_ctx) { const int nrow = k + 1 < 8 ? row + 256 : ML + g;
#pragma unroll
            for (int i = 0; i < 8; ++i) vn[i] = *(const f32x4*)(norm_src(p, l, from_input, nrow) + 4 * (lane + 64 * i)); }
        finish(row);
#pragma unroll
        for (int i = 0; i < 8; ++i) v[i] = vn[i];
    }
    if (has_ctx) {
        const int row = ML + g;
        load_mod(8);
        const bool fold_mlp = (l == 1 && which == 0), fold_mix = (l == 0 && which == 1);
        if (fold_mlp || fold_mix) {
            const float* part = (fold_mlp ? (const float*)p->mix : (const float*)p->big) + (size_t)g * DM;
            const float* gt = p->mod + (size_t)8 * 12288 + (fold_mlp ? 10240 : 4096);
#pragma unroll
            for (int hf = 0; hf < 2; ++hf) {
                f32x4 pa[4], pb[4], pc[4], pd[4], gg[4];
#pragma unroll
                for (int i = 0; i < 4; ++i) { const int col = 4 * (lane + 64 * (4 * hf + i));
                    pa[i] = *(const f32x4*)(part + col); pb[i] = *(const f32x4*)(part + (size_t)MC * DM + col); pc[i] = *(const f32x4*)(part + (size_t)2 * MC * DM + col); pd[i] = *(const f32x4*)(part + (size_t)3 * MC * DM + col);
                    gg[i] = *(const f32x4*)(gt + col); }
#pragma unroll
                for (int i = 0; i < 4; ++i) v[4 * hf + i] += gg[i] * ((pa[i] + pb[i]) + (pc[i] + pd[i]));
            }
            if (fold_mix) {
                float* xo = p->xc + (size_t)g * DM;
#pragma unroll
                for (int i = 0; i < 8; ++i) *(f32x4*)(xo + 4 * (lane + 64 * i)) = v[i]; }
        }
        finish(row);
    }
}
__device__ void final_norm_phase(KParams p) {
    const int tid = tid_o(), wave = tid >> 6, lane = tid & 63;
    const int nrows = ML >> 11, row0 = bid_o() * 8 + wave;
    f32x4 v[8], vn[8], w[8];
#pragma unroll
    for (int i = 0; i < 8; ++i) { v[i] = *(const f32x4*)(p->out + (size_t)row0 * DM + 4 * (lane + 64 * i)); w[i] = *(const f32x4*)(p->fnw + 4 * (lane + 64 * i)); }
    for (int k = 0; k < nrows; ++k) {
        float* src = p->out + (size_t)(row0 + 2048 * k) * DM;
        if (k + 1 < nrows) {
#pragma unroll
            for (int i = 0; i < 8; ++i) vn[i] = *(const f32x4*)(src + (size_t)2048 * DM + 4 * (lane + 64 * i)); }
        float ss = 0.f;
#pragma unroll
        for (int i = 0; i < 8; ++i) ss += v[i][0] * v[i][0] + v[i][1] * v[i][1] + v[i][2] * v[i][2] + v[i][3] * v[i][3];
#pragma unroll
        for (int o = 32; o >= 1; o >>= 1) ss += __shfl_xor(ss, o);
        const float rstd = rsqrtf(ss * (1.0f / DM) + 1e-6f);
#pragma unroll
        for (int i = 0; i < 8; ++i) *(f32x4*)(src + 4 * (lane + 64 * i)) = v[i] * rstd * w[i];
#pragma unroll
        for (int i = 0; i < 8; ++i) v[i] = vn[i];
    }
}

constexpr int QS = 136, KES = 72;
__device__ __forceinline__ int hg_chunk_base(int b, int dir, int n) {
    if (n < 4) { const int ci = dir ? 3 - n : n; return ML + b * CT + ci * 64; }
    const int cn = n - 4; const int ci = dir ? 31 - cn : cn; return b * TL + ci * 64;
}
__device__ void hgA_item(KParams p, int l, int item, LAS unsigned char* lds) {
    const int tid = tid_o(), wid = tid >> 6, lane = tid & 63, fr = lane & 15, fq = lane >> 4;
    LAS bf16_t* QI = (LAS bf16_t*)lds;
    LAS bf16_t* KI = QI + 64 * QS;
    LAS bf16_t* KE = KI + 160 * QS;
    LAS bf16_t* VT = KE + 128 * KES;
    LAS float* F8 = (LAS float*)(VT + 128 * KES);
    LAS bf16_t* QFl = (LAS bf16_t*)(F8 + 1024);
    const int seq = item / 36, n = item - seq * 36;
    const int dir = seq & 1, hh = (seq >> 1) & 3, b = seq >> 3;
    const int dp = lane, tb = wid, I = tb >> 1;
    const int Iw = wid >> 1, vh = wid & 1;
    float lb[2] = {0.f, 0.f};
    if (l == 1) {
#pragma unroll
        for (int e = 0; e < 2; ++e) { const float l0 = p->lb_logits[dir * 512 + hh * 128 + 2 * dp + e], l1 = p->lb_logits[1024 + dir * 512 + hh * 128 + 2 * dp + e]; lb[e] = __builtin_amdgcn_rcpf(1.0f + __expf(l0 - l1)); } }
    const bf16_t* P = p->big;
    bf16_t* ohg = p->h + (size_t)dir * MT * 512;
    const int base = hg_chunk_base(b, dir, n);
    const bool skip_out = (l == 1 && n < 4);
    bf16_t* qfg = p->qfg + (size_t)item * 64 * 128;
    bf16_t* ug = p->ug + (size_t)item * 128 * 128;
    float pr[2][8], qv[2][8], kv[2][8];
    {
        unsigned xw[8], qw[8];
#pragma unroll
        for (int i = 0; i < 8; ++i) { const int tau = 8 * tb + i; const bf16_t* rowp = P + (size_t)(base + (dir ? 63 - tau : tau)) * NIN + hh * 128 + 2 * dp;
            xw[i] = *(const unsigned*)(rowp + C_HF + dir * 512); qw[i] = *(const unsigned*)(rowp + C_HQ); }
#pragma unroll
        for (int e = 0; e < 2; ++e) {
            const float omlb = 1.0f - lb[e];
            float run = 1.0f;
#pragma unroll
            for (int i = 0; i < 8; ++i) {
                const float x = e ? bfhi(xw[i]) : bflo(xw[i]), q = e ? bfhi(qw[i]) : bflo(qw[i]);
                const float ex = __expf(-fabsf(x));
                const float r = __builtin_amdgcn_rcpf(1.0f + ex);
                const float sp = x >= 0.f ? r : ex * r, sn = x >= 0.f ? ex * r : r;
                run *= lb[e] + omlb * sp;
                pr[e][i] = run;
                kv[e][i] = omlb * sn;
                qv[e][i] = q * __builtin_amdgcn_rcpf(1.0f + __expf(-q)) * 0.08838834764831845f;
            }
        }
        typedef float f32x2v __attribute__((ext_vector_type(2)));
        *(LAS f32x2v*)(F8 + tb * 128 + 2 * dp) = (f32x2v){pr[0][7], pr[1][7]};
    }
    { const int tau = tid >> 3, vc = tid & 7; const size_t row = (size_t)(base + (dir ? 63 - tau : tau));
      const bf16_t* srcv = P + row * NIN + C_HI + hh * 128 + 16 * vc;
      const u32x4 w0 = *(const u32x4*)srcv, w1 = *(const u32x4*)(srcv + 8);
      LAS bf16_t* dst = VT + (16 * vc) * KES + (tau ^ (8 * vc));
      dst[0 * KES] = (bf16_t)(w0.x & 0xffffu); dst[1 * KES] = (bf16_t)(w0.x >> 16); dst[2 * KES] = (bf16_t)(w0.y & 0xffffu); dst[3 * KES] = (bf16_t)(w0.y >> 16);
      dst[4 * KES] = (bf16_t)(w0.z & 0xffffu); dst[5 * KES] = (bf16_t)(w0.z >> 16); dst[6 * KES] = (bf16_t)(w0.w & 0xffffu); dst[7 * KES] = (bf16_t)(w0.w >> 16);
      dst[8 * KES] = (bf16_t)(w1.x & 0xffffu); dst[9 * KES] = (bf16_t)(w1.x >> 16); dst[10 * KES] = (bf16_t)(w1.y & 0xffffu); dst[11 * KES] = (bf16_t)(w1.y >> 16);
      dst[12 * KES] = (bf16_t)(w1.z & 0xffffu); dst[13 * KES] = (bf16_t)(w1.z >> 16); dst[14 * KES] = (bf16_t)(w1.w & 0xffffu); dst[15 * KES] = (bf16_t)(w1.w >> 16); }
    lds_barrier();
    {
        typedef float f32x2v __attribute__((ext_vector_type(2)));
        f32x2v F[8];
#pragma unroll
        for (int j = 0; j < 8; ++j) F[j] = *(const LAS f32x2v*)(F8 + j * 128 + 2 * dp);
        const f32x2v one = (f32x2v){1.0f, 1.0f};
        f32x2v eRI = one, eEnd = one, eK[4], hf = one;
#pragma unroll
        for (int j = 0; j < 8; ++j) { if (j < 2 * I) eRI *= F[j]; else eEnd *= F[j]; if (j == tb - 1 && (tb & 1)) hf = F[j]; }
        { f32x2v run = one;
#pragma unroll
          for (int Ip = 0; Ip < 4; ++Ip) { if (Ip > I) run *= F[2 * Ip - 2 < 0 ? 0 : 2 * Ip - 2] * F[2 * Ip - 1 < 0 ? 0 : 2 * Ip - 1]; eK[Ip] = run; } }
        unsigned kew[2][4];
#pragma unroll
        for (int i = 0; i < 8; ++i) {
            const int tau = 8 * tb + i;
            float qi[2], ke[2];
#pragma unroll
            for (int e = 0; e < 2; ++e) { const float ep = pr[e][i] * hf[e]; const float en = __builtin_amdgcn_rcpf(fmaxf(ep, 1.8e-35f)); qi[e] = qv[e][i] * ep; ke[e] = kv[e][i] * en; }
            *(LAS unsigned*)(QI + tau * QS + 2 * dp) = cvt_pk_bf16(qi[0], qi[1]);
            *(LAS unsigned*)(QFl + tau * QS + 2 * dp) = cvt_pk_bf16(qi[0] * eRI[0], qi[1] * eRI[1]);
#pragma unroll
            for (int Ip = 0; Ip < 4; ++Ip) if (Ip >= I) *(LAS unsigned*)(KI + (16 * ((Ip * (Ip + 1)) >> 1) + tau) * QS + 2 * dp) = cvt_pk_bf16(ke[0] * eK[Ip][0], ke[1] * eK[Ip][1]);
            const float k0 = ke[0] * eEnd[0], k1 = ke[1] * eEnd[1];
            if (i & 1) { kew[0][i >> 1] = cvt_pk_bf16(kv[0][i - 1], k0); kew[1][i >> 1] = cvt_pk_bf16(kv[1][i - 1], k1); } else { kv[0][i] = k0; kv[1][i] = k1; }
        }
#pragma unroll
        for (int e = 0; e < 2; ++e) { u32x4 w; w.x = kew[e][0]; w.y = kew[e][1]; w.z = kew[e][2]; w.w = kew[e][3]; *(LAS u32x4*)(KE + (2 * dp + e) * KES + 8 * tb) = w; }
        if (tb == 0) { typedef float f32x2g __attribute__((ext_vector_type(2))); *(f32x2g*)(p->aeg + (size_t)item * 128 + 2 * dp) = (f32x2g){eEnd[0], eEnd[1]}; }
    }
    lds_barrier();
#pragma unroll
    for (int k = 0; k < 4; ++k) { const int g = tid + 512 * k, ln = g & 63, half = (g >> 6) & 1, ks = (g >> 7) & 3, mt = g >> 9;
        const u32x2 w = *(const LAS u32x2*)(QFl + (16 * mt + (ln & 15)) * QS + 32 * ks + 16 * half + 4 * (ln >> 4));
        *(u32x2*)(qfg + (size_t)g * 4) = w; }
    if (!skip_out) {
        const int koff = 16 * ((Iw * (Iw + 1)) >> 1);
        bf16x8 qb[4];
#pragma unroll
        for (int ks = 0; ks < 4; ++ks) qb[ks] = *(const LAS bf16x8*)(QI + (16 * Iw + fr) * QS + 32 * ks + 8 * fq);
        f32x4 at[4];
#pragma unroll
        for (int J = 0; J < 4; ++J) {
            at[J] = (f32x4){0.f, 0.f, 0.f, 0.f};
            if (J <= Iw) {
#pragma unroll
                for (int ks = 0; ks < 4; ++ks) { const bf16x8 a = *(const LAS bf16x8*)(KI + (koff + 16 * J + fr) * QS + 32 * ks + 8 * fq); at[J] = __builtin_amdgcn_mfma_f32_16x16x32_bf16(a, qb[ks], at[J], 0, 0, 0); }
                mfma_settle(at[J]);
                if (J == Iw) {
#pragma unroll
                    for (int r = 0; r < 4; ++r) if (4 * fq + r > fr) at[J][r] = 0.f; }
            }
        }
        u32x4 aw[2];
#pragma unroll
        for (int kp = 0; kp < 2; ++kp) { aw[kp].x = cvt_pk_bf16(at[2 * kp][0], at[2 * kp][1]); aw[kp].y = cvt_pk_bf16(at[2 * kp][2], at[2 * kp][3]); aw[kp].z = cvt_pk_bf16(at[2 * kp + 1][0], at[2 * kp + 1][1]); aw[kp].w = cvt_pk_bf16(at[2 * kp + 1][2], at[2 * kp + 1][3]); }
#pragma unroll
        for (int nt = 0; nt < 4; ++nt) {
            const int vrow = vh * 64 + nt * 16 + fr;
            f32x4 oacc = (f32x4){0.f, 0.f, 0.f, 0.f};
#pragma unroll
            for (int kp = 0; kp < 2; ++kp) {
                const int sw = 8 * (vh * 4 + nt);
                const u32x2 b0 = *(const LAS u32x2*)(VT + vrow * KES + ((32 * kp + 4 * fq) ^ sw)), b1 = *(const LAS u32x2*)(VT + vrow * KES + ((32 * kp + 16 + 4 * fq) ^ sw));
                u32x4 bw; bw.x = b0.x; bw.y = b0.y; bw.z = b1.x; bw.w = b1.y;
                oacc = __builtin_amdgcn_mfma_f32_16x16x32_bf16(__builtin_bit_cast(bf16x8, aw[kp]), __builtin_bit_cast(bf16x8, bw), oacc, 0, 0, 0);
            }
            mfma_settle(oacc);
#pragma unroll
            for (int r = 0; r < 4; ++r) { const int tau = 16 * Iw + 4 * fq + r; const size_t row = (size_t)(base + (dir ? 63 - tau : tau));
                ohg[row * 512 + hh * 128 + vrow] = f2bf(oacc[r]); }
        }
    }
    {
        bf16x8 ka[2];
#pragma unroll
        for (int ks = 0; ks < 2; ++ks) ka[ks] = *(const LAS bf16x8*)(KE + (16 * wid + fr) * KES + 32 * ks + 8 * fq);
#pragma unroll
        for (int nt = 0; nt < 8; ++nt) {
            f32x4 u = (f32x4){0.f, 0.f, 0.f, 0.f};
#pragma unroll
            for (int ks = 0; ks < 2; ++ks) { const bf16x8 bv = *(const LAS bf16x8*)(VT + (16 * nt + fr) * KES + ((32 * ks + 8 * fq) ^ (8 * nt))); u = __builtin_amdgcn_mfma_f32_16x16x32_bf16(ka[ks], bv, u, 0, 0, 0); }
            mfma_settle(u);
            u32x2 o; o.x = cvt_pk_bf16(u[0], u[1]); o.y = cvt_pk_bf16(u[2], u[3]);
            *(u32x2*)(ug + ((nt * 8 + wid) * 64 + lane) * 4) = o;
        }
    }
    lds_barrier();
}

struct HgUA { u32x2 u[8]; f32x4 ae[8]; };
__device__ __forceinline__ void hgB_load_u(HgUA& s, KParams p, int c, int wid, int lane, int fq) {
    const bf16_t* ug = p->ug + (size_t)c * 128 * 128 + (wid * 8 * 64 + lane) * 4;
    const float* ae = p->aeg + (size_t)c * 128 + 4 * fq;
#pragma unroll
    for (int m = 0; m < 8; ++m) { s.u[m] = *(const u32x2*)(ug + m * 256); s.ae[m] = *(const f32x4*)(ae + 16 * m); }
}
__device__ void hgB_seq(KParams p, int l, int seq, LAS unsigned char* lds) {
    const int tid = tid_o(), wid = tid >> 6, lane = tid & 63, fr = lane & 15, fq = lane >> 4;
    const int dir = seq & 1, hh = (seq >> 1) & 3, b = seq >> 3;
    const int vs = wid >> 1, vt = wid & 1;
    bf16_t* oib = p->oib + (size_t)((dir * 4 + hh) * 4 + vs) * MT * 32 + vt * 16 + fr;
    f32x4 S[8];
#pragma unroll
    for (int m = 0; m < 8; ++m) S[m] = (f32x4){0.f, 0.f, 0.f, 0.f};
    const bf16_t* qsrc = p->qfg + (size_t)seq * 36 * 64 * 128 + tid * 16;
    u32x4 qr0[2], qr1[2];
    { const u32x4 a0 = *(const u32x4*)qsrc, a1 = *(const u32x4*)(qsrc + 8);
      *(LAS u32x4*)(lds + tid * 32) = a0; *(LAS u32x4*)(lds + tid * 32 + 16) = a1; }
    qr0[0] = *(const u32x4*)(qsrc + 8192); qr0[1] = *(const u32x4*)(qsrc + 8192 + 8);
    qr1[0] = *(const u32x4*)(qsrc + 2 * 8192); qr1[1] = *(const u32x4*)(qsrc + 2 * 8192 + 8);
    HgUA sA, sB;
    hgB_load_u(sA, p, seq * 36, wid, lane, fq); hgB_load_u(sB, p, seq * 36 + 1, wid, lane, fq);
    auto step = [&](HgUA& s, int n) {
        if (n + 1 < 36) { LAS unsigned char* d = lds + ((n + 1) % 3) * 16384 + tid * 32; *(LAS u32x4*)d = qr0[0]; *(LAS u32x4*)(d + 16) = qr0[1]; }
        qr0[0] = qr1[0]; qr0[1] = qr1[1];
        if (n + 3 < 36) { qr1[0] = *(const u32x4*)(qsrc + (size_t)(n + 3) * 8192); qr1[1] = *(const u32x4*)(qsrc + (size_t)(n + 3) * 8192 + 8); }
        lds_barrier();
        const bool skip_out = (l == 1 && n < 4);
        if (!skip_out) {
            const int base = hg_chunk_base(b, dir, n);
            const LAS unsigned char* qf = lds + (n % 3) * 16384 + lane * 8;
            u32x4 bw[4];
#pragma unroll
            for (int ks = 0; ks < 4; ++ks) { bw[ks].x = cvt_pk_bf16(S[2 * ks][0], S[2 * ks][1]); bw[ks].y = cvt_pk_bf16(S[2 * ks][2], S[2 * ks][3]); bw[ks].z = cvt_pk_bf16(S[2 * ks + 1][0], S[2 * ks + 1][1]); bw[ks].w = cvt_pk_bf16(S[2 * ks + 1][2], S[2 * ks + 1][3]); }
            f32x4 oacc[4];
#pragma unroll
            for (int mt = 0; mt < 4; ++mt) {
                oacc[mt] = (f32x4){0.f, 0.f, 0.f, 0.f};
#pragma unroll
                for (int ks = 0; ks < 4; ++ks) {
                    const u32x2 qa = *(const LAS u32x2*)(qf + ((mt * 4 + ks) * 2 + 0) * 512), qc = *(const LAS u32x2*)(qf + ((mt * 4 + ks) * 2 + 1) * 512);
                    u32x4 aw; aw.x = qa.x; aw.y = qa.y; aw.z = qc.x; aw.w = qc.y;
                    oacc[mt] = __builtin_amdgcn_mfma_f32_16x16x32_bf16(__builtin_bit_cast(bf16x8, aw), __builtin_bit_cast(bf16x8, bw[ks]), oacc[mt], 0, 0, 0);
                }
            }
            asm volatile("s_nop 7\n\ts_nop 7\n\ts_nop 3" : "+v"(oacc[0]), "+v"(oacc[1]), "+v"(oacc[2]), "+v"(oacc[3]));
#pragma unroll
            for (int mt = 0; mt < 4; ++mt)
#pragma unroll
                for (int r = 0; r < 4; ++r) { const int tau = 16 * mt + 4 * fq + r; oib[(size_t)(base + (dir ? 63 - tau : tau)) * 32] = f2bf(oacc[mt][r]); }
        }
#pragma unroll
        for (int m = 0; m < 8; ++m) {
            S[m][0] = S[m][0] * s.ae[m][0] + bflo(s.u[m].x); S[m][1] = S[m][1] * s.ae[m][1] + bfhi(s.u[m].x);
            S[m][2] = S[m][2] * s.ae[m][2] + bflo(s.u[m].y); S[m][3] = S[m][3] * s.ae[m][3] + bfhi(s.u[m].y);
        }
        if (n + 2 < 36) hgB_load_u(s, p, seq * 36 + n + 2, wid, lane, fq);
    };
    for (int n = 0; n < 36; n += 2) { step(sA, n); step(sB, n + 1); }
    asm volatile("s_waitcnt vmcnt(0)" ::: "memory");
    __syncthreads();
    if (threadIdx.x == 0) { __builtin_amdgcn_fence(__ATOMIC_RELEASE, "agent"); asm volatile("s_waitcnt vmcnt(0)" ::: "memory"); __hip_atomic_fetch_add(p->bar + 3456 + 64 * 3 + 16 * l, 1u, __ATOMIC_RELAXED, __HIP_MEMORY_SCOPE_AGENT); }
}

constexpr int VS = 72;
constexpr int NA_KT = 64 * QS * 2, NA_VT = 128 * VS * 2, NA_BUF = NA_KT + NA_VT;
__device__ void na_item(KParams p, int l, int item, LAS unsigned char* lds) {
    const int tid = tid_o(), wid = tid >> 6, lane = tid & 63, fr = lane & 15, fq = lane >> 4;
    LAS float* RPB = (LAS float*)(lds + 2 * NA_BUF);
    const bf16_t* P = p->big;
    const float LOG2E = 1.4426950408889634f;
    const bool is_lat = item < 512;
    int b, hh, g4 = 0;
    if (is_lat) { g4 = item & 7; hh = (item >> 3) & 7; b = item >> 6; } else { const int it = item - 512; hh = it & 7; b = it >> 3; }
    const int j = wid & 3;
    int rq[2] = {0, 0}, r0w[2] = {0, 0}, qtok0[2];
#pragma unroll
    for (int t = 0; t < 2; ++t) {
        if (is_lat) { rq[t] = 4 * g4 + (wid >> 2) + 2 * t; r0w[t] = min(max(rq[t] - 4, 0), 24); qtok0[t] = b * TL + rq[t] * 64 + 16 * j; }
        else qtok0[t] = ML + b * CT + t * 128 + 16 * wid;
    }
    const int r0a = min(max(4 * g4 - 4, 0), 24), r0b = min(max(4 * g4 + 3 - 4, 0), 24);
    const int nlat = is_lat ? (r0b + 8 - r0a) : 0, nst = nlat + 4;
    const int kst = (j == 0) ? 0 : (j == 1) ? 8 : (j == 2) ? 24 : 32;
    if (is_lat) { const float* rp_src = p->rpb + ((size_t)l * 8 + hh) * 465; for (int i = tid; i < 465; i += 512) RPB[i] = rp_src[i] * LOG2E; }
    bf16x8 qb[2][4];
#pragma unroll
    for (int t = 0; t < 2; ++t)
#pragma unroll
        for (int ks = 0; ks < 4; ++ks) qb[t][ks] = *(const bf16x8*)(P + (size_t)(qtok0[t] + fr) * NIN + C_NAQ + hh * 128 + 32 * ks + 8 * fq);
    float m_run[2] = {-INFINITY, -INFINITY}, l_run[2] = {0.f, 0.f};
    f32x4 O[2][8];
#pragma unroll
    for (int t = 0; t < 2; ++t)
#pragma unroll
        for (int m = 0; m < 8; ++m) O[t][m] = (f32x4){0.f, 0.f, 0.f, 0.f};
    const float sc2 = 0.08838834764831845f * LOG2E;
    const int qc = 16 * j + fr, wst = min(max(qc - 8, 0), 48);
    int dcolv[8]; unsigned vmask = 0u;
#pragma unroll
    for (int i = 0; i < 8; ++i) { const int kc2 = kst + 16 * (i >> 2) + 4 * fq + (i & 3); dcolv[i] = min(max(kc2 - qc, -15), 15) + 15; vmask |= ((kc2 >= wst) && (kc2 < wst + 16)) ? (1u << i) : 0u; }
    const int skey = tid >> 3, sc = tid & 7;
    auto stage_tok = [&](int st) { return st < nlat ? (b * TL + (r0a + st) * 64) : (ML + b * CT + 64 * (st - nlat)); };
    auto loadKV = [&](u32x4 (&k)[2], u32x4 (&v)[2], int st) {
        const bf16_t* srow = P + (size_t)(stage_tok(st) + skey) * NIN + hh * 128 + 16 * sc;
        k[0] = *(const u32x4*)(srow + C_NAK); k[1] = *(const u32x4*)(srow + C_NAK + 8);
        v[0] = *(const u32x4*)(srow + C_NAV); v[1] = *(const u32x4*)(srow + C_NAV + 8);
    };
    u32x4 kq0[2], vq0[2];
    loadKV(kq0, vq0, 0);

    for (int st = 0; st < nst; ++st) {
        const bool lat_st = st < nlat;
        const int rk = r0a + st;
        LAS bf16_t* KT = (LAS bf16_t*)(lds + (st & 1) * NA_BUF);
        LAS bf16_t* VT = (LAS bf16_t*)(lds + (st & 1) * NA_BUF + NA_KT);
        { *(LAS u32x4*)(KT + skey * QS + 16 * sc) = kq0[0]; *(LAS u32x4*)(KT + skey * QS + 16 * sc + 8) = kq0[1];
          const u32x4 w0 = vq0[0], w1 = vq0[1];
          LAS bf16_t* dst = VT + (16 * sc) * VS + (skey ^ (8 * sc));
          dst[0 * VS] = (bf16_t)(w0.x & 0xffffu); dst[1 * VS] = (bf16_t)(w0.x >> 16); dst[2 * VS] = (bf16_t)(w0.y & 0xffffu); dst[3 * VS] = (bf16_t)(w0.y >> 16);
          dst[4 * VS] = (bf16_t)(w0.z & 0xffffu); dst[5 * VS] = (bf16_t)(w0.z >> 16); dst[6 * VS] = (bf16_t)(w0.w & 0xffffu); dst[7 * VS] = (bf16_t)(w0.w >> 16);
          dst[8 * VS] = (bf16_t)(w1.x & 0xffffu); dst[9 * VS] = (bf16_t)(w1.x >> 16); dst[10 * VS] = (bf16_t)(w1.y & 0xffffu); dst[11 * VS] = (bf16_t)(w1.y >> 16);
          dst[12 * VS] = (bf16_t)(w1.z & 0xffffu); dst[13 * VS] = (bf16_t)(w1.z >> 16); dst[14 * VS] = (bf16_t)(w1.w & 0xffffu); dst[15 * VS] = (bf16_t)(w1.w >> 16); }
        if (st + 1 < nst) loadKV(kq0, vq0, st + 1);
        lds_barrier();
        bool act[2];
#pragma unroll
        for (int t = 0; t < 2; ++t) act[t] = lat_st ? (rk >= r0w[t] && rk < r0w[t] + 8) : true;
        if (act[0] || act[1]) {
            const int nsub = lat_st ? 1 : 2;
            for (int sub = 0; sub < nsub; ++sub) {
                const int k0 = lat_st ? kst : 32 * sub;
                bf16x8 kf[8];
#pragma unroll
                for (int a = 0; a < 2; ++a)
#pragma unroll
                    for (int ks = 0; ks < 4; ++ks) kf[a * 4 + ks] = *(const LAS bf16x8*)(KT + (k0 + 16 * a + fr) * QS + 32 * ks + 8 * fq);
                float alpha[2]; bf16x8 pb[2];
#pragma unroll
                for (int t = 0; t < 2; ++t) {
                    f32x4 sa[2];
#pragma unroll
                    for (int a = 0; a < 2; ++a) {
                        sa[a] = (f32x4){0.f, 0.f, 0.f, 0.f};
#pragma unroll
                        for (int ks = 0; ks < 4; ++ks) sa[a] = __builtin_amdgcn_mfma_f32_16x16x32_bf16(kf[a * 4 + ks], qb[t][ks], sa[a], 0, 0, 0);
                    }
                    float s2[8];
                    if (lat_st) {
                        const LAS float* rpr = RPB + min(max(rk - rq[t] + 7, 0), 14) * 31;
                        const unsigned vm = act[t] ? vmask : 0u;
#pragma unroll
                        for (int i = 0; i < 8; ++i) s2[i] = rpr[dcolv[i]];
#pragma unroll
                        for (int i = 0; i < 8; ++i) s2[i] = (vm >> i) & 1 ? sa[i >> 2][i & 3] * sc2 + s2[i] : -INFINITY;
                    } else {
#pragma unroll
                        for (int i = 0; i < 8; ++i) s2[i] = sa[i >> 2][i & 3] * sc2;
                    }
                    float mx = s2[0];
#pragma unroll
                    for (int i = 1; i < 8; ++i) mx = fmaxf(mx, s2[i]);
                    mx = rowmax4(mx);
                    const float m_new = fmaxf(m_run[t], mx);
                    const float m_safe = (m_new == -INFINITY) ? 0.f : m_new;
                    alpha[t] = __builtin_amdgcn_exp2f(m_run[t] - m_safe);
                    float ps = 0.f; float pe[8];
#pragma unroll
                    for (int i = 0; i < 8; ++i) { pe[i] = __builtin_amdgcn_exp2f(s2[i] - m_safe); ps += pe[i]; }
                    l_run[t] = l_run[t] * alpha[t] + ps; m_run[t] = m_new;
                    u32x4 pw; pw.x = cvt_pk_bf16(pe[0], pe[1]); pw.y = cvt_pk_bf16(pe[2], pe[3]); pw.z = cvt_pk_bf16(pe[4], pe[5]); pw.w = cvt_pk_bf16(pe[6], pe[7]);
                    pb[t] = __builtin_bit_cast(bf16x8, pw);
                }
#pragma unroll
                for (int m = 0; m < 8; ++m) {
                    const u32x2 a0 = *(const LAS u32x2*)(VT + (16 * m + fr) * VS + ((k0 + 4 * fq) ^ (8 * m))), a1 = *(const LAS u32x2*)(VT + (16 * m + fr) * VS + ((k0 + 16 + 4 * fq) ^ (8 * m)));
                    u32x4 aw; aw.x = a0.x; aw.y = a0.y; aw.z = a1.x; aw.w = a1.y;
#pragma unroll
                    for (int t = 0; t < 2; ++t) { O[t][m] *= alpha[t]; O[t][m] = __builtin_amdgcn_mfma_f32_16x16x32_bf16(__builtin_bit_cast(bf16x8, aw), pb[t], O[t][m], 0, 0, 0); }
                }
            }
        }
    }
#pragma unroll
    for (int t = 0; t < 2; ++t) {
        const float lr = rowsum4(l_run[t]);
        const float inv = 1.0f / lr;
        bf16_t* dst = p->mix + (size_t)(qtok0[t] + fr) * DM + hh * 128 + 4 * fq;
#pragma unroll
        for (int m = 0; m < 8; ++m) { u32x2 o; o.x = cvt_pk_bf16(O[t][m][0] * inv, O[t][m][1] * inv); o.y = cvt_pk_bf16(O[t][m][2] * inv, O[t][m][3] * inv); *(u32x2*)(dst + 16 * m) = o; }
    }
    __syncthreads();
}

__device__ void gm_item(KParams p, int l, int item, LAS unsigned char* lds) {
    const int tid = tid_o(), wid = tid >> 6, lane = tid & 63, fr = lane & 15, fq = lane >> 4;
    LAS bf16_t* VNT = (LAS bf16_t*)lds;
    LAS bf16_t* WS = VNT + 128 * QS;
    const bf16_t* P = p->big;
    const int g = item & 3, row0 = (item >> 2) * 128;
    const int q = tid >> 2, part = tid & 3;
    const int pr = 16 * wid + fr;
    u32x4 vw[4]; f32x4 lwv[8], wsv[8]; u32x2 uwv[8];
    { const bf16_t* src = P + (size_t)(row0 + q) * NIN + C_GV + g * 128;
      const float* lw = p->gm_lnw + l * 512 + g * 128;
      const float* wsrc = p->gm_ws + (((size_t)l * 4 + g) * 128 + q) * 128;
#pragma unroll
      for (int i = 0; i < 4; ++i) { vw[i] = *(const u32x4*)(src + 8 * (part + 4 * i)); lwv[2 * i] = *(const f32x4*)(lw + 8 * (part + 4 * i)); lwv[2 * i + 1] = *(const f32x4*)(lw + 8 * (part + 4 * i) + 4); }
#pragma unroll
      for (int i = 0; i < 8; ++i) wsv[i] = *(const f32x4*)(wsrc + 4 * (part + 4 * i)); }
    const float bsv = p->gm_bs[(l * 4 + g) * 128 + pr];
    const bf16_t* usrc = P + (size_t)(row0 + pr) * NIN + C_GU + g * 128 + 4 * fq;
#pragma unroll
    for (int m = 0; m < 8; ++m) uwv[m] = *(const u32x2*)(usrc + 16 * m);
    {
        float vf[32];
#pragma unroll
        for (int i = 0; i < 4; ++i) { const u32x4 w = vw[i];
            vf[8 * i + 0] = gelu_tanh(bflo(w.x)); vf[8 * i + 1] = gelu_tanh(bfhi(w.x)); vf[8 * i + 2] = gelu_tanh(bflo(w.y)); vf[8 * i + 3] = gelu_tanh(bfhi(w.y));
            vf[8 * i + 4] = gelu_tanh(bflo(w.z)); vf[8 * i + 5] = gelu_tanh(bfhi(w.z)); vf[8 * i + 6] = gelu_tanh(bflo(w.w)); vf[8 * i + 7] = gelu_tanh(bfhi(w.w)); }
        float s = 0.f;
#pragma unroll
        for (int i = 0; i < 32; ++i) s += vf[i];
        s += __shfl_xor(s, 1); s += __shfl_xor(s, 2);
        const float mu = s * (1.0f / 128.0f);
        float qq = 0.f;
#pragma unroll
        for (int i = 0; i < 32; ++i) { const float dlt = vf[i] - mu; qq += dlt * dlt; }
        qq += __shfl_xor(qq, 1); qq += __shfl_xor(qq, 2);
        const float rstd = rsqrtf(qq * (1.0f / 128.0f) + 1e-6f);
        const int qs = q ^ (8 * part);
#pragma unroll
        for (int i = 0; i < 4; ++i)
#pragma unroll
            for (int e = 0; e < 8; ++e) VNT[(8 * (part + 4 * i) + e) * QS + qs] = f2bf((vf[8 * i + e] - mu) * rstd * lwv[2 * i + (e >> 2)][e & 3]);
#pragma unroll
        for (int i = 0; i < 8; ++i) { u32x2 w; w.x = cvt_pk_bf16(wsv[i][0], wsv[i][1]); w.y = cvt_pk_bf16(wsv[i][2], wsv[i][3]); *(LAS u32x2*)(WS + q * QS + 4 * (part + 4 * i)) = w; }
    }
    __syncthreads();
    {
        bf16x8 bfr[4];
#pragma unroll
        for (int ks = 0; ks < 4; ++ks) bfr[ks] = *(const LAS bf16x8*)(WS + (16 * wid + fr) * QS + 32 * ks + 8 * fq);
        bf16_t* dst = p->mix + (size_t)(row0 + pr) * DM + 1536 + g * 128 + 4 * fq;
#pragma unroll
        for (int m = 0; m < 8; ++m) {
            f32x4 acc = (f32x4){0.f, 0.f, 0.f, 0.f};
            const int sw = 8 * ((2 * m + (fr >> 3)) & 3);
#pragma unroll
            for (int ks = 0; ks < 4; ++ks) { const bf16x8 a = *(const LAS bf16x8*)(VNT + (16 * m + fr) * QS + ((32 * ks + 8 * fq) ^ sw)); acc = __builtin_amdgcn_mfma_f32_16x16x32_bf16(a, bfr[ks], acc, 0, 0, 0); }
            const u32x2 uw = uwv[m];
            const float o0 = gelu_tanh(bflo(uw.x)) * (acc[0] + bsv), o1 = gelu_tanh(bfhi(uw.x)) * (acc[1] + bsv), o2 = gelu_tanh(bflo(uw.y)) * (acc[2] + bsv), o3 = gelu_tanh(bfhi(uw.y)) * (acc[3] + bsv);
            u32x2 o; o.x = cvt_pk_bf16(o0, o1); o.y = cvt_pk_bf16(o2, o3); *(u32x2*)(dst + 16 * m) = o;
        }
    }
    __syncthreads();
}

__device__ void gatenorm_item(KParams p, int l, int item) {
    const int tid = tid_o(), wave = tid >> 6, lane = tid & 63;
    const bf16_t* o0 = p->h; const bf16_t* o1 = o0 + (size_t)MT * 512;
    const float* nw = p->hg_nw + l * 128 + 8 * (lane & 15);
    const f32x4 w0 = *(const f32x4*)nw, w1 = *(const f32x4*)(nw + 4);
    for (int half = 0; half < 2; ++half) {
        const int rbase = item * 64 + wave * 8 + 4 * half;
        u32x4 x0[4], x1[4], i0[4], i1[4], gw[4];
#pragma unroll
        for (int j = 0; j < 4; ++j) { const int row = rbase + j; const size_t off = (size_t)row * 512 + 8 * lane;
            const size_t ioff = ((size_t)(lane >> 2) * MT + row) * 32 + 8 * (lane & 3);
            x0[j] = *(const u32x4*)(o0 + off); x1[j] = *(const u32x4*)(o1 + off);
            i0[j] = *(const u32x4*)(p->oib + ioff); i1[j] = *(const u32x4*)(p->oib + (size_t)16 * MT * 32 + ioff);
            gw[j] = *(const u32x4*)(p->big + (size_t)row * NIN + C_HG + 8 * lane); }
#pragma unroll
        for (int j = 0; j < 4; ++j) { const int row = rbase + j;
            f32x4 a0, a1;
            a0[0] = bflo(x0[j].x) + bflo(x1[j].x) + bflo(i0[j].x) + bflo(i1[j].x); a0[1] = bfhi(x0[j].x) + bfhi(x1[j].x) + bfhi(i0[j].x) + bfhi(i1[j].x);
            a0[2] = bflo(x0[j].y) + bflo(x1[j].y) + bflo(i0[j].y) + bflo(i1[j].y); a0[3] = bfhi(x0[j].y) + bfhi(x1[j].y) + bfhi(i0[j].y) + bfhi(i1[j].y);
            a1[0] = bflo(x0[j].z) + bflo(x1[j].z) + bflo(i0[j].z) + bflo(i1[j].z); a1[1] = bfhi(x0[j].z) + bfhi(x1[j].z) + bfhi(i0[j].z) + bfhi(i1[j].z);
            a1[2] = bflo(x0[j].w) + bflo(x1[j].w) + bflo(i0[j].w) + bflo(i1[j].w); a1[3] = bfhi(x0[j].w) + bfhi(x1[j].w) + bfhi(i0[j].w) + bfhi(i1[j].w);
            float ss = a0[0] * a0[0] + a0[1] * a0[1] + a0[2] * a0[2] + a0[3] * a0[3] + a1[0] * a1[0] + a1[1] * a1[1] + a1[2] * a1[2] + a1[3] * a1[3];
            ss += __shfl_xor(ss, 1); ss += __shfl_xor(ss, 2); ss += __shfl_xor(ss, 4); ss += __shfl_xor(ss, 8);
            const float rstd = rsqrtf(ss * (1.0f / 128.0f) + 1e-6f);
            const u32x4 g = gw[j];
            const float g0 = silu_f(bflo(g.x)), g1 = silu_f(bfhi(g.x)), g2 = silu_f(bflo(g.y)), g3 = silu_f(bfhi(g.y)), g4 = silu_f(bflo(g.z)), g5 = silu_f(bfhi(g.z)), g6 = silu_f(bflo(g.w)), g7 = silu_f(bfhi(g.w));
            u32x4 o; o.x = cvt_pk_bf16(a0[0] * rstd * w0[0] * g0, a0[1] * rstd * w0[1] * g1); o.y = cvt_pk_bf16(a0[2] * rstd * w0[2] * g2, a0[3] * rstd * w0[3] * g3);
            o.z = cvt_pk_bf16(a1[0] * rstd * w1[0] * g4, a1[1] * rstd * w1[1] * g5); o.w = cvt_pk_bf16(a1[2] * rstd * w1[2] * g6, a1[3] * rstd * w1[3] * g7);
            *(u32x4*)(p->mix + (size_t)row * DM + 1024 + 8 * lane) = o; }
    }
}

__device__ void hgA_phase(KParams p, int l, LAS unsigned char* lds) {
    for (int it = bid_o(); it < 64 * 36; it += gridDim.x) hgA_item(p, l, it, lds);
}
__device__ void mixer_phase(KParams p, int l, LAS unsigned char* lds) {
    if (bid_o() < 64) hgB_seq(p, l, bid_o(), lds);
    const int n_na = (l == 0) ? 512 + 64 : 512, n_gm = (l == 0) ? 576 : 512, n_gn = ((l == 0) ? MT : ML) / 64;
    unsigned* ctr = p->bar + 3456 + 64 * l;
    unsigned* done = p->bar + 3456 + 64 * 3 + 16 * l;
    volatile LAS unsigned* slot = (volatile LAS unsigned*)(lds + 131072 + 16);
    bool gn_ready = false;
    int it = next_item(ctr, slot);
    while (it < n_na + n_gm + n_gn) {
        unsigned nxt = 0u;
        if (threadIdx.x == 0) nxt = atomicAdd(ctr, 1u);
        if (it < n_na) na_item(p, l, it, lds);
        else if (it < n_na + n_gm) gm_item(p, l, it - n_na, lds);
        else {
            if (!gn_ready) {
                if (threadIdx.x == 0) { unsigned sp = 0u;
                    while (__hip_atomic_load(done, __ATOMIC_RELAXED, __HIP_MEMORY_SCOPE_AGENT) < 64u && ++sp < (1u << 22)) __builtin_amdgcn_s_sleep(8);
                    __builtin_amdgcn_fence(__ATOMIC_ACQUIRE, "agent"); asm volatile("s_waitcnt vmcnt(0)" ::: "memory"); }
                __syncthreads(); gn_ready = true; }
            gatenorm_item(p, l, it - n_na - n_gm);
            __syncthreads();
        }
        if (threadIdx.x == 0) *slot = nxt;
        __syncthreads();
        it = (int)*slot;
    }
}

#define XB_TMO      128
#define XB_XCNT(j)  (256  + 64 * (j))
#define XB_XSUB(j)  (1280 + 64 * (j))
#define XB_XGEN(j)  (2304 + 64 * (j))
#define XB_TOP      3328
#define XB_TOPGEN   3392
#define XCD_BAR_WORDS 3456
#define XB_SPIN_CAP (1u << 18)
__device__ __forceinline__ unsigned xb_ld(unsigned* p)              { return __hip_atomic_load(p, __ATOMIC_RELAXED, __HIP_MEMORY_SCOPE_AGENT); }
__device__ __forceinline__ unsigned xb_add(unsigned* p, unsigned v) { return __hip_atomic_fetch_add(p, v, __ATOMIC_RELAXED, __HIP_MEMORY_SCOPE_AGENT); }
__device__ __forceinline__ unsigned xb_xcc_id() { return (unsigned)__builtin_amdgcn_s_getreg((3 << 11) | 20) & 0xFu; }
#define XB_SPIN(cond, bar) do { unsigned _sp = 0; while (cond) { __builtin_amdgcn_s_sleep(1); \
    if ((++_sp & 255u) == 0u) { if (xb_ld(&(bar)[XB_TMO])) break; if (_sp > XB_SPIN_CAP) { atomicAdd(&(bar)[XB_TMO], 1u); break; } } } } while (0)
struct XcdBarrier { unsigned* bar; unsigned x; volatile LAS unsigned* st; };
__device__ __forceinline__ XcdBarrier xcd_barrier_post(unsigned* bar, volatile LAS unsigned* st) {
    XcdBarrier b; b.bar = bar; b.x = xb_xcc_id(); b.st = st;
    if (threadIdx.x == 0) (void)xb_add(&bar[XB_XCNT(b.x)], 1u);
    return b;
}
__device__ __forceinline__ void xcd_barrier_complete(unsigned* bar, unsigned x, unsigned& nloc, unsigned& nx) {
    const unsigned G = gridDim.x * gridDim.y * gridDim.z;
    unsigned sum, cnt, mine, sp = 0u;
    for (;;) {
        sum = 0u; cnt = 0u; mine = 0u;
#pragma unroll
        for (unsigned j = 0; j < 16; ++j) { const unsigned c = xb_ld(&bar[XB_XCNT(j)]); sum += c; cnt += (c > 0u) ? 1u : 0u; mine = (j == x) ? c : mine; }
        if (sum == G) break;
        __builtin_amdgcn_s_sleep(1);
        if ((++sp & 255u) == 0u) { if (xb_ld(&bar[XB_TMO])) break; if (sp > XB_SPIN_CAP) { atomicAdd(&bar[XB_TMO], 1u); break; } }
    }
    nloc = mine > 0u ? mine : 1u; nx = cnt > 0u ? cnt : 1u;
}
__device__ __forceinline__ void xcd_barrier(const XcdBarrier& b) {
    asm volatile("s_waitcnt vmcnt(0)" ::: "memory");
    __syncthreads();
    if (threadIdx.x == 0) {
        unsigned* bar = b.bar;
        __builtin_amdgcn_s_waitcnt(0);
        unsigned nloc = b.st[0], nx = b.st[1];
        if (nloc == 0u) { xcd_barrier_complete(bar, b.x, nloc, nx); b.st[0] = nloc; b.st[1] = nx; }
        const unsigned old = xb_add(&bar[XB_XSUB(b.x)], 1u);
        const unsigned gen = old / nloc;
        if (old + 1u == (gen + 1u) * nloc) {
            __builtin_amdgcn_fence(__ATOMIC_RELEASE, "agent");
            asm volatile("s_waitcnt vmcnt(0)" ::: "memory");
            const unsigned og = xb_add(&bar[XB_TOP], 1u);
            const unsigned tg = og / nx;
            if (og + 1u == (tg + 1u) * nx) xb_add(&bar[XB_TOPGEN], 1u);
            else XB_SPIN(xb_ld(&bar[XB_TOPGEN]) == tg, bar);
            __builtin_amdgcn_fence(__ATOMIC_ACQUIRE, "agent");
            xb_add(&bar[XB_XGEN(b.x)], 1u);
            asm volatile("s_waitcnt vmcnt(0)" ::: "memory");
        } else {
            XB_SPIN(xb_ld(&bar[XB_XGEN(b.x)]) == gen, bar);
            __builtin_amdgcn_fence(__ATOMIC_ACQUIRE, "agent");
            asm volatile("s_waitcnt vmcnt(0)" ::: "memory");
        }
    }
    __syncthreads();
}

__device__ __forceinline__ void run_phase(KParams p, int ph, LAS unsigned char* lds) {
    if (ph == 0) { prepass(p, lds); return; }
    if (ph == NPHASE - 1) { final_norm_phase(p); return; }
    const int l = (ph - 1) / NPL, s = (ph - 1) % NPL;
    const int Mx = (l == 0) ? MT : ML;
    const bf16_t* wt = p->wt + (size_t)l * WT_LAYER;
    const float* modl = p->mod + (size_t)l * 9 * 12288;
    switch (s) {
    case 0: case 5: norm_phase(p, l, s == 5 ? 1 : 0, s == 5 ? Mx : MT); break;
    case 1: { pg8::EpiBf16<0> E; E.O = p->big; E.ldc = NIN; pg8::InOrder S; S.init((int)gridDim.x, bid_o(), l == 1); run_gemm_s(lds, p->h, wt + WT_IN, MT, NIN, DM, DM, S, E);
              if (l == 0 && bid_o() >= 80) {
                  const int b2 = bid_o() - 80; const int n_it = (2048 - b2 + 175) / 176;
                  transpose_tiles(p, lds, n_it, [&](int k) { return 4224 + b2 + 176 * k; }); } } break;
    case 2: hgA_phase(p, l, lds); break;
    case 3: mixer_phase(p, l, lds); break;
    case 4: { pg8::EpiRes E; E.src_lat = (l == 0) ? p->x : p->out; E.src_ctx = (l == 0) ? p->ctx : p->xc; E.dst_lat = p->out; E.dst_ctx = p->xc; E.gate = modl + 4096;
              run_gemm(lds, p->mix, wt + WT_OUT, ML, DM, DM, E);
              if (l == 0) {
                  pg8::EpiPart EP; EP.part = (float*)p->big; EP.Mp = MC; EP.ldc = DM;
                  pg8::SplitOrder S; S.init(MC, DM, 4, (int)gridDim.x, bid_o());
                  run_gemm_s(lds, p->mix + (size_t)ML * DM, wt + WT_OUT, MC, DM, DM / 4, DM, S, EP); } } break;
    case 6: { pg8::EpiBf16<1> E; E.O = p->big; E.ldc = HID; run_gemm(lds, p->h, wt + WT_1, Mx, HID, DM, E); } break;
    case 7: { pg8::EpiRes E; E.src_lat = p->out; E.src_ctx = p->xc; E.dst_lat = p->out; E.dst_ctx = p->xc; E.gate = modl + 10240;
              run_gemm(lds, p->big, wt + WT_2, ML, DM, HID, E);
              if (l == 0) {
                  pg8::EpiPart EP; EP.part = (float*)p->mix; EP.Mp = MC; EP.ldc = DM;
                  pg8::SplitOrder S; S.init(MC, DM, 4, (int)gridDim.x, bid_o());
                  run_gemm_s(lds, p->big + (size_t)ML * HID, wt + WT_2, MC, DM, HID / 4, HID, S, EP); } } break;
    }
}

#ifndef DUP_MASK
#define DUP_MASK 0
#endif
__global__ void __launch_bounds__(512, 2) mega(Params p_arg, int ph_lo, int ph_hi) {
    extern __shared__ __attribute__((aligned(16))) unsigned char shm[];
    LAS unsigned char* lds = (LAS unsigned char*)shm;
    volatile LAS unsigned* st = (volatile LAS unsigned*)(lds + 131072);
    if (threadIdx.x == 0) { st[0] = 0u; st[1] = 0u; }
    __syncthreads();
    XcdBarrier xb = xcd_barrier_post(p_arg.bar, st);
    for (int ph = ph_lo; ph < ph_hi; ++ph) {
        KParams p = (KParams)__builtin_amdgcn_kernarg_segment_ptr();
        asm volatile("" : "+s"(p));
        run_phase(p, ph, lds);
        if (DUP_MASK) { const int s = (ph - 1) % NPL; if (ph >= 1 && ph < NPHASE - 1 && ((DUP_MASK >> s) & 1)) { __syncthreads(); run_phase(p, ph, lds); } }
        if (ph + 1 < ph_hi) {
            if (ph_hi > NPHASE) { __threadfence(); cg::this_grid().sync(); }
            else xcd_barrier(xb);
        }
    }
}

extern "C" void kernel_launch(void* const* d_in, const int* in_sizes, int n_in, void* d_out, int out_size, void* d_ws, size_t ws_size, hipStream_t stream) {
    static int grid_blocks = 0;
    if (!grid_blocks) {
        hipFuncSetAttribute((const void*)mega, hipFuncAttributeMaxDynamicSharedMemorySize, LDS_BYTES);
        int dev = 0, cus = 0, per_cu = 0;
        hipGetDevice(&dev);
        hipDeviceGetAttribute(&cus, hipDeviceAttributeMultiprocessorCount, dev);
        hipOccupancyMaxActiveBlocksPerMultiprocessor(&per_cu, mega, 512, LDS_BYTES);
        if (per_cu < 1) per_cu = 1;
        grid_blocks = cus * 1;
        if (grid_blocks > 256) grid_blocks = 256;
    }
    Params p{};
    p.x = (const float*)d_in[0]; p.c = (const float*)d_in[1]; p.ctx = (const float*)d_in[2]; p.c_ctx = (const float*)d_in[3];
    p.ada_w = (const float*)d_in[4]; p.ada_b = (const float*)d_in[5]; p.n1w = (const float*)d_in[6]; p.n2w = (const float*)d_in[7];
    p.w_in = (const float*)d_in[8]; p.rpb = (const float*)d_in[9]; p.lb_logits = (const float*)d_in[10]; p.hg_nw = (const float*)d_in[11];
    p.gm_lnw = (const float*)d_in[12]; p.gm_ws = (const float*)d_in[13]; p.gm_bs = (const float*)d_in[14]; p.w_out = (const float*)d_in[15];
    p.w1 = (const float*)d_in[16]; p.w2 = (const float*)d_in[17]; p.fnw = (const float*)d_in[18];
    p.out = (float*)d_out;
    char* ws = (char*)d_ws; size_t o = 0;
    auto take = [&](size_t bytes) { char* r = ws + o; o += (bytes + 255) & ~(size_t)255; return r; };
    p.wt = (bf16_t*)take(2 * WT_LAYER * 2);
    p.xc = (float*)take((size_t)MC * DM * 4);
    p.h = (bf16_t*)take((size_t)MT * DM * 2);
    p.mix = (bf16_t*)take((size_t)MT * DM * 2);
    p.big = (bf16_t*)take((size_t)MT * HID * 2 + (size_t)60 * 1024 * 1024);
    { char* q = (char*)p.big + (size_t)MT * NIN * 2; p.ug = (bf16_t*)q; q += (size_t)2304 * 128 * 128 * 2; p.qfg = (bf16_t*)q; q += (size_t)2304 * 64 * 128 * 2; p.aeg = (float*)q; }
    p.mod = (float*)take((size_t)2 * 9 * 12288 * 4);
    p.oib = (bf16_t*)take((size_t)2 * MT * 512 * 2);
    p.bar = (unsigned*)take((size_t)(XCD_BAR_WORDS + 256) * 4);
    if (o > ws_size) { fprintf(stderr, "workspace too small: need %zu have %zu\n", o, ws_size); return; }
    if (hipMemsetAsync(p.bar, 0, (size_t)(XCD_BAR_WORDS + 256) * 4, stream) != hipSuccess) { fprintf(stderr, "memset failed\n"); return; }
#if ONE_LAUNCH
    int lo = 0, hi = NPHASE;
    void* args[] = {&p, &lo, &hi};
    hipError_t e = hipLaunchCooperativeKernel((const void*)mega, dim3(grid_blocks), dim3(512), args, LDS_BYTES, stream);
    if (e != hipSuccess) fprintf(stderr, "cooperative launch failed: %s (grid %d)\n", hipGetErrorString(e), grid_blocks);
#else
    for (int ph = 0; ph < NPHASE; ++ph) hipLaunchKernelGGL(mega, dim3(grid_blocks), dim3(512), LDS_BYTES, stream, p, ph, ph + 1);
#endif
}
```

```cpp
#include <hip/hip_runtime.h>
#include <hip/hip_cooperative_groups.h>
#include <cstdio>
namespace cg = cooperative_groups;

#ifndef ONE_LAUNCH
#define ONE_LAUNCH 1
#endif

#define LAS __attribute__((address_space(3)))
typedef unsigned short bf16_t;
typedef short bf16x8 __attribute__((ext_vector_type(8)));
typedef short s16x4 __attribute__((ext_vector_type(4)));
typedef float f32x4 __attribute__((ext_vector_type(4)));
typedef unsigned u32x4 __attribute__((ext_vector_type(4)));
typedef unsigned u32x2 __attribute__((ext_vector_type(2)));

constexpr int DM = 2048, NB = 8, TL = 2048, CT = 256, ML = NB * TL, MC = NB * CT, MT = ML + MC;
constexpr int NIN = 6656, HID = 8192;
constexpr size_t WT_IN = 0, WT_OUT = (size_t)NIN * DM, WT_1 = WT_OUT + (size_t)DM * DM, WT_2 = WT_1 + (size_t)HID * DM, WT_LAYER = WT_2 + (size_t)DM * HID;
constexpr int LDS_BYTES = 131072 + 64;
constexpr int NPL = 8;
constexpr int NPHASE = 2 + 2 * NPL;
constexpr int C_NAQ = 0, C_NAK = 1024, C_NAV = 2048, C_HQ = 3072, C_HF = 3584, C_HI = 4608, C_HG = 5120, C_GU = 5632, C_GV = 6144;

struct Params {
    const float *x, *c, *ctx, *c_ctx, *ada_w, *ada_b, *n1w, *n2w, *w_in, *rpb, *lb_logits, *hg_nw, *gm_lnw, *gm_ws, *gm_bs, *w_out, *w1, *w2, *fnw;
    float* out;
    float* xc;
    bf16_t* wt;
    bf16_t* h;
    bf16_t* mix;
    bf16_t* big;
    float* mod;
    unsigned* bar;
    bf16_t* ug;
    bf16_t* qfg;
    float* aeg;
    bf16_t* oib;
};
typedef const Params __attribute__((address_space(4)))* KParams;

__device__ __forceinline__ unsigned cvt_pk_bf16(float lo, float hi) { unsigned r; asm("v_cvt_pk_bf16_f32 %0, %1, %2" : "=v"(r) : "v"(lo), "v"(hi)); return r; }
__device__ __forceinline__ float bf2f(bf16_t b) { return __uint_as_float(((unsigned)b) << 16); }
__device__ __forceinline__ float bflo(unsigned w) { return __uint_as_float(w << 16); }
__device__ __forceinline__ float bfhi(unsigned w) { return __uint_as_float(w & 0xffff0000u); }
__device__ __forceinline__ bf16_t f2bf(float f) { return (bf16_t)(cvt_pk_bf16(f, 0.f) & 0xffffu); }
__device__ __forceinline__ void mfma_settle(f32x4& a) { asm volatile("s_nop 7\n\ts_nop 7\n\ts_nop 3" : "+v"(a)); }
__device__ __forceinline__ float rowmax4(float x) {
    auto r = __builtin_amdgcn_permlane16_swap(__float_as_uint(x), __float_as_uint(x), false, false); x = fmaxf(__uint_as_float(r[0]), __uint_as_float(r[1]));
    auto s = __builtin_amdgcn_permlane32_swap(__float_as_uint(x), __float_as_uint(x), false, false); return fmaxf(__uint_as_float(s[0]), __uint_as_float(s[1]));
}
__device__ __forceinline__ float rowsum4(float x) {
    auto r = __builtin_amdgcn_permlane16_swap(__float_as_uint(x), __float_as_uint(x), false, false); x = __uint_as_float(r[0]) + __uint_as_float(r[1]);
    auto s = __builtin_amdgcn_permlane32_swap(__float_as_uint(x), __float_as_uint(x), false, false); return __uint_as_float(s[0]) + __uint_as_float(s[1]);
}
__device__ __forceinline__ int tid_o() { int t = (int)threadIdx.x; asm volatile("" : "+v"(t)); return t; }
__device__ __forceinline__ int bid_o() { int t = (int)blockIdx.x; asm volatile("" : "+s"(t)); return t; }
__device__ __forceinline__ int next_item(unsigned* ctr, volatile LAS unsigned* slot) {
    __syncthreads();
    if (threadIdx.x == 0) *slot = atomicAdd(ctr, 1u);
    __syncthreads();
    return (int)*slot;
}
__device__ __forceinline__ float gelu_tanh(float x) { const float z = 0.7978845608028654f * (x + 0.044715f * x * x * x); return x * __builtin_amdgcn_rcpf(1.0f + __expf(-2.0f * z)); }
__device__ __forceinline__ float silu_f(float x) { return x * __builtin_amdgcn_rcpf(1.0f + __expf(-x)); }

namespace pg8 {
constexpr int BM = 256, BK = 64, HALF = 128, HTB = HALF * BK * 2, STAGE_BYTES = 8 * HTB, NXCD = 8, WGM = 8;
__device__ __forceinline__ int lds_byte(int r, int c) { const int st = (r >> 4) * 2 + (c >> 5), rr = r & 15, cc = c & 31, ob = rr * 64 + cc * 2; return st * 1024 + (ob ^ (((ob >> 9) & 1) << 5)); }
__device__ __forceinline__ void stage_rc(int b, int& R, int& C) { const int st = b / 1024, sb = b % 1024, swz = sb ^ (((sb >> 9) & 1) << 5); R = (st >> 1) * 16 + swz / 64; C = (st & 1) * 32 + (swz % 64) / 2; }
__device__ __forceinline__ int perm32(int rho) { const int n = rho >> 4, i = rho & 15; return 8 * (i >> 2) + 4 * n + (i & 3); }
struct Unit { int pm, pn, ks; };
struct Gemm { const bf16_t* A; const bf16_t* Bt; int M, N, K; int ld; };
struct StaticOrder {
    int nM, nN, nwg, G, c;
    __device__ void init(int M, int N, int G_, int c_) { nM = M / BM; nN = N / BM; nwg = nM * nN; G = G_; c = c_; }
    __device__ bool next(int i, Unit& u) const {
        const long L = (long)i * G + c; if (L >= nwg) return false;
        int wgid = (int)L; { const int q = nwg / NXCD, r = nwg % NXCD, xcd = wgid % NXCD, off = wgid / NXCD; wgid = (xcd < r ? xcd * (q + 1) : r * (q + 1) + (xcd - r) * q) + off; }
        const int nig = WGM * nN, gid = wgid / nig, fm = gid * WGM, gsz = (nM - fm) < WGM ? (nM - fm) : WGM;
        u.pm = fm + ((wgid % nig) % gsz); u.pn = (wgid % nig) / gsz; u.ks = 0; return true;
    }
};

struct InOrder {
    StaticOrder lat; int G, c, ncc, trim;
    __device__ void init(int G_, int c_, int trim_) { lat.init(16384, 6656, G_, c_); G = G_; c = c_; trim = trim_; ncc = trim_ ? 14 : 26; }
    __device__ bool next(int i, Unit& u) const {
        const int L = i * G + c;
        if (L < 1664) return lat.next(i, u);
        const int e = L - 1664; if (e >= 8 * ncc) return false;
        const int cr = e / ncc, ci = e - cr * ncc;
        u.pm = 64 + cr; u.pn = trim ? (ci < 8 ? 4 + ci : 6 + ci) : ci; u.ks = 0; return true;
    }
};
struct SplitOrder {
    int nM, nN, nS, G, c;
    __device__ void init(int M, int N, int nS_, int G_, int c_) { nM = M / BM; nN = N / BM; nS = nS_; G = G_; c = c_; }
    __device__ bool next(int i, Unit& u) const {
        const int L = i * G + c; if (L >= nM * nN * nS) return false;
        u.ks = L / (nM * nN); const int r = L - u.ks * (nM * nN); u.pn = r / nM; u.pm = r - u.pn * nM; return true;
    }
};
template <int ACT  > struct EpiBf16 {
    static constexpr bool PERM = true;
    bf16_t* O; int ldc;
    __device__ __forceinline__ void operator()(const f32x4 (&acc)[2][2][4][2], const Unit& u, int wr, int wc, int fr, int fq) const {
        const int row0 = u.pm * BM + wr * 64 + fr, col0 = u.pn * BM + wc * 32 + 8 * fq;
#pragma unroll
        for (int ai = 0; ai < 2; ++ai)
#pragma unroll
            for (int m = 0; m < 4; ++m) { bf16_t* rowp = O + (size_t)(row0 + ai * HALF + m * 16) * ldc + col0;
#pragma unroll
                for (int bj = 0; bj < 2; ++bj) { f32x4 v0 = acc[ai][bj][m][0], v1 = acc[ai][bj][m][1];
                    if (ACT == 1) {
#pragma unroll
                        for (int j = 0; j < 4; ++j) { float a = fmaxf(v0[j], 0.f), b = fmaxf(v1[j], 0.f); v0[j] = a * a; v1[j] = b * b; } }
                    u32x4 w; w.x = cvt_pk_bf16(v0[0], v0[1]); w.y = cvt_pk_bf16(v0[2], v0[3]); w.z = cvt_pk_bf16(v1[0], v1[1]); w.w = cvt_pk_bf16(v1[2], v1[3]);
                    *(u32x4*)(rowp + bj * HALF) = w; } }
    }
};
struct EpiRes {
    static constexpr bool PERM = false;
    const float* src_lat; const float* src_ctx; float* dst_lat; float* dst_ctx; const float* gate;
    __device__ __forceinline__ void operator()(const f32x4 (&acc)[2][2][4][2], const Unit& u, int wr, int wc, int fr, int fq) const {
        const bool lat = u.pm < 64; const int r = lat ? (u.pm >> 3) : 8;
        const float* s = lat ? src_lat : src_ctx; float* d = lat ? dst_lat : dst_ctx;
        const int row0 = (lat ? u.pm : u.pm - 64) * BM + wr * 64 + fr, col0 = u.pn * BM + wc * 32 + 4 * fq;
        const float* g = gate + (size_t)r * 12288 + col0;
        f32x4 gv[2][2];
#pragma unroll
        for (int bj = 0; bj < 2; ++bj)
#pragma unroll
            for (int n = 0; n < 2; ++n) gv[bj][n] = *(const f32x4*)(g + bj * HALF + n * 16);
        f32x4 xc[2][2], xn[2][2];
#pragma unroll
        for (int bj = 0; bj < 2; ++bj)
#pragma unroll
            for (int n = 0; n < 2; ++n) xc[bj][n] = *(const f32x4*)(s + (size_t)row0 * DM + col0 + bj * HALF + n * 16);
#pragma unroll
        for (int gi = 0; gi < 8; ++gi) { const int ai = gi >> 2, m = gi & 3; const size_t off = (size_t)(row0 + ai * HALF + m * 16) * DM + col0;
            if (gi + 1 < 8) { const int ai2 = (gi + 1) >> 2, m2 = (gi + 1) & 3; const size_t off2 = (size_t)(row0 + ai2 * HALF + m2 * 16) * DM + col0;
#pragma unroll
                for (int bj = 0; bj < 2; ++bj)
#pragma unroll
                    for (int n = 0; n < 2; ++n) xn[bj][n] = *(const f32x4*)(s + off2 + bj * HALF + n * 16); }
#pragma unroll
            for (int bj = 0; bj < 2; ++bj)
#pragma unroll
                for (int n = 0; n < 2; ++n) *(f32x4*)(d + off + bj * HALF + n * 16) = xc[bj][n] + gv[bj][n] * acc[ai][bj][m][n];
#pragma unroll
            for (int bj = 0; bj < 2; ++bj)
#pragma unroll
                for (int n = 0; n < 2; ++n) xc[bj][n] = xn[bj][n]; }
    }
};

struct EpiPart {
    static constexpr bool PERM = false;
    float* part; int Mp, ldc;
    __device__ __forceinline__ void operator()(const f32x4 (&acc)[2][2][4][2], const Unit& u, int wr, int wc, int fr, int fq) const {
        const int row0 = u.pm * BM + wr * 64 + fr, col0 = u.pn * BM + wc * 32 + 4 * fq;
        float* base = part + (size_t)u.ks * Mp * ldc;
#pragma unroll
        for (int ai = 0; ai < 2; ++ai)
#pragma unroll
            for (int m = 0; m < 4; ++m) { float* rowp = base + (size_t)(row0 + ai * HALF + m * 16) * ldc + col0;
#pragma unroll
                for (int bj = 0; bj < 2; ++bj)
#pragma unroll
                    for (int n = 0; n < 2; ++n) *(f32x4*)(rowp + bj * HALF + n * 16) = acc[ai][bj][m][n]; }
    }
};

template <class Epi, class Sched>
__device__ __forceinline__ void gemm_phase(LAS unsigned char* lds, const Gemm g, const Sched& S, const Epi& E) {
    const int tid = tid_o(), wid = __builtin_amdgcn_readfirstlane(tid >> 6), lane = tid & 63, wr = wid >> 2, wc = wid & 3, fr = lane & 15, fq = lane >> 4;
    const int K = g.K, nt = K / BK;
    unsigned voffA[2], voffB[2];
#pragma unroll
    for (int i = 0; i < 2; ++i) { int R, C; stage_rc(tid * 16 + i * 8192, R, C); const int Rb = Epi::PERM ? ((R & ~31) + perm32(R & 31)) : R;
        voffA[i] = (unsigned)(R * g.ld + C) * 2u; voffB[i] = (unsigned)(Rb * g.ld + C) * 2u; }
    const size_t kstep = (size_t)(BK * 2);
    const size_t hstep = (size_t)HALF * g.ld * 2;
    const size_t tstep = 2 * hstep, sstep = (size_t)K * 2;
    const unsigned ldsw = (unsigned)wid * 1024u;
    const int aoff = lds_byte(wr * 64 + fr, fq * 8), boff = lds_byte(wc * 32 + fr, fq * 8);
#define PG8_SA(b, h) (((b) * 2 + (h)) * HTB)
#define PG8_SB(b, h) ((4 + (b) * 2 + (h)) * HTB)
#define PG8_STAGE(bufoff, gbase, voff) do { _Pragma("unroll") for (int _i = 0; _i < 2; ++_i) \
        __builtin_amdgcn_global_load_lds((const unsigned*)((const char*)(gbase) + (voff)[_i]), (LAS unsigned*)(lds + (bufoff) + ldsw + _i * 8192), 16, 0, 0); } while (0)
#define PG8_LDA(dst, b, h) do { _Pragma("unroll") for (int m = 0; m < 4; ++m) _Pragma("unroll") for (int k = 0; k < 2; ++k) dst[m][k] = *(const LAS bf16x8*)(lds + PG8_SA(b, h) + aoff + m * 2048 + k * 1024); } while (0)
#define PG8_LDB(dst, b, h) do { _Pragma("unroll") for (int n = 0; n < 2; ++n) _Pragma("unroll") for (int k = 0; k < 2; ++k) dst[n][k] = *(const LAS bf16x8*)(lds + PG8_SB(b, h) + boff + n * 2048 + k * 1024); } while (0)
#define PG8_MMA(ai, bj, At, Bt) do { __builtin_amdgcn_s_setprio(1); _Pragma("unroll") for (int m = 0; m < 4; ++m) _Pragma("unroll") for (int n = 0; n < 2; ++n) _Pragma("unroll") for (int k = 0; k < 2; ++k) \
        acc[ai][bj][m][n] = __builtin_amdgcn_mfma_f32_16x16x32_bf16(Bt[n][k], At[m][k], acc[ai][bj][m][n], 0, 0, 0); __builtin_amdgcn_s_setprio(0); } while (0)
#define PG8_WAIT_V(n) asm volatile("s_waitcnt vmcnt(" #n ")" ::: "memory")
#define PG8_WAIT_L(n) asm volatile("s_waitcnt lgkmcnt(" #n ")" ::: "memory")
#define PG8_BAR __builtin_amdgcn_s_barrier()
#define PG8_SCHED __builtin_amdgcn_sched_barrier(0)
    Unit cur, nxt; int ui = 0;
    if (!S.next(0, cur)) return;
    f32x4 acc[2][2][4][2];
#pragma unroll
    for (int a = 0; a < 2; ++a)
#pragma unroll
        for (int b = 0; b < 2; ++b)
#pragma unroll
            for (int m = 0; m < 4; ++m)
#pragma unroll
                for (int n = 0; n < 2; ++n) acc[a][b][m][n] = (f32x4){0.f, 0.f, 0.f, 0.f};
    bf16x8 At[4][2], B0[2][2], B1[2][2];
    const char* cA = (const char*)g.A + (size_t)cur.pm * tstep + (size_t)cur.ks * sstep; const char* cB = (const char*)g.Bt + (size_t)cur.pn * tstep + (size_t)cur.ks * sstep;
    PG8_STAGE(PG8_SB(0, 0), cB, voffB); PG8_STAGE(PG8_SA(0, 0), cA, voffA); PG8_STAGE(PG8_SB(0, 1), cB + hstep, voffB); PG8_STAGE(PG8_SA(0, 1), cA + hstep, voffA);
    if (wr == 1) PG8_BAR;
    PG8_WAIT_V(4); PG8_BAR;
    PG8_STAGE(PG8_SB(1, 0), cB + kstep, voffB); PG8_STAGE(PG8_SA(1, 0), cA + kstep, voffA); PG8_STAGE(PG8_SB(1, 1), cB + hstep + kstep, voffB);
    PG8_WAIT_V(6); PG8_BAR;
    for (;;) {
        const bool has_next = S.next(ui + 1, nxt);
        const char* nA = has_next ? (const char*)g.A + (size_t)nxt.pm * tstep + (size_t)nxt.ks * sstep : cA; const char* nB = has_next ? (const char*)g.Bt + (size_t)nxt.pn * tstep + (size_t)nxt.ks * sstep : cB;
        for (int t = 0; t < nt; t += 2) {
            const bool last = (t == nt - 2);
            const char* a1 = cA + (size_t)(t + 1) * kstep;
            const char* a2 = last ? nA : cA + (size_t)(t + 2) * kstep; const char* b2 = last ? nB : cB + (size_t)(t + 2) * kstep;
            const char* a3 = a2 + kstep; const char* b3 = b2 + kstep;
            PG8_LDB(B0, 0, 0); PG8_SCHED; PG8_LDA(At, 0, 0); PG8_STAGE(PG8_SA(1, 1), a1 + hstep, voffA);
            PG8_WAIT_L(8); PG8_BAR; PG8_WAIT_L(0); PG8_MMA(0, 0, At, B0); PG8_BAR; PG8_SCHED;
            PG8_LDB(B1, 0, 1); PG8_STAGE(PG8_SB(0, 0), b2, voffB);
            PG8_BAR; PG8_WAIT_L(0); PG8_MMA(0, 1, At, B1); PG8_BAR;
            PG8_LDA(At, 0, 1); PG8_STAGE(PG8_SA(0, 0), a2, voffA);
            PG8_BAR; PG8_WAIT_L(0); PG8_MMA(1, 0, At, B0); PG8_BAR; PG8_SCHED;
            PG8_STAGE(PG8_SB(0, 1), b2 + hstep, voffB);
            PG8_WAIT_V(6); PG8_BAR; PG8_MMA(1, 1, At, B1); PG8_BAR;
            PG8_LDB(B0, 1, 0); PG8_SCHED; PG8_LDA(At, 1, 0); PG8_STAGE(PG8_SA(0, 1), a2 + hstep, voffA);
            PG8_WAIT_L(8); PG8_BAR; PG8_WAIT_L(0); PG8_MMA(0, 0, At, B0); PG8_BAR; PG8_SCHED;
            PG8_LDB(B1, 1, 1); PG8_STAGE(PG8_SB(1, 0), b3, voffB);
            PG8_BAR; PG8_WAIT_L(0); PG8_MMA(0, 1, At, B1); PG8_BAR;
            PG8_LDA(At, 1, 1); PG8_STAGE(PG8_SA(1, 0), a3, voffA);
            PG8_BAR; PG8_WAIT_L(0); PG8_MMA(1, 0, At, B0); PG8_BAR; PG8_SCHED;
            PG8_STAGE(PG8_SB(1, 1), b3 + hstep, voffB);
            PG8_WAIT_V(6); PG8_BAR; PG8_MMA(1, 1, At, B1); PG8_BAR;
        }
        E(acc, cur, wr, wc, fr, fq);
        if (!has_next) break;
#pragma unroll
        for (int a = 0; a < 2; ++a)
#pragma unroll
            for (int b = 0; b < 2; ++b)
#pragma unroll
                for (int m = 0; m < 4; ++m)
#pragma unroll
                    for (int n = 0; n < 2; ++n) acc[a][b][m][n] = (f32x4){0.f, 0.f, 0.f, 0.f};
        cur = nxt; cA = nA; cB = nB; ++ui;
    }
    PG8_WAIT_V(0);
    if (wr == 0) PG8_BAR;
    PG8_BAR;
#undef PG8_SA
#undef PG8_SB
#undef PG8_STAGE
#undef PG8_LDA
#undef PG8_LDB
#undef PG8_MMA
#undef PG8_WAIT_V
#undef PG8_WAIT_L
#undef PG8_BAR
#undef PG8_SCHED
}
}

template <class Epi>
__device__ __forceinline__ void run_gemm(LAS unsigned char* lds, const bf16_t* A, const bf16_t* Bt, int M, int N, int K, const Epi& E) {
    pg8::Gemm g; g.A = A; g.Bt = Bt; g.M = M; g.N = N; g.K = K; g.ld = K;
    pg8::StaticOrder S; S.init(M, N, (int)gridDim.x, bid_o());
    pg8::gemm_phase(lds, g, S, E);
    __syncthreads();
}
template <class Epi, class Sched>
__device__ __forceinline__ void run_gemm_s(LAS unsigned char* lds, const bf16_t* A, const bf16_t* Bt, int M, int N, int K, int ld, const Sched& S, const Epi& E) {
    pg8::Gemm g; g.A = A; g.Bt = Bt; g.M = M; g.N = N; g.K = K; g.ld = ld;
    pg8::gemm_phase(lds, g, S, E);
    __syncthreads();
}

__device__ void ada_prep(KParams p, LAS unsigned char* lds) {
    LAS float* sc = (LAS float*)lds;
    const int tid = tid_o();
    for (int i = tid; i < 9 * 2048; i += 512) { const int r = i >> 11, d = i & 2047; const float v = r < 8 ? p->c[r * 2048 + d] : p->c_ctx[d]; sc[i] = silu_f(v); }
    __syncthreads();
}
__device__ void ada_item(KParams p, int item, LAS unsigned char* lds) {
    LAS float* sc = (LAS float*)lds;
    LAS float* red = sc + 9 * 2048;
    const int tid = tid_o();
    {
        const int l = item / 96, cb = item % 96, tx = tid & 31, ty = tid >> 5;
        const float* W = p->ada_w + (size_t)l * 2048 * 12288 + cb * 128 + tx * 4;
        f32x4 acc[9];
#pragma unroll
        for (int r = 0; r < 9; ++r) acc[r] = (f32x4){0.f, 0.f, 0.f, 0.f};
#pragma unroll 8
        for (int dd = 0; dd < 128; ++dd) { const int d = ty * 128 + dd; const f32x4 w = *(const f32x4*)(W + (size_t)d * 12288);
#pragma unroll
            for (int r = 0; r < 9; ++r) acc[r] += sc[r * 2048 + d] * w; }
#pragma unroll
        for (int r = 0; r < 9; ++r)
#pragma unroll
            for (int j = 0; j < 4; ++j) acc[r][j] += __shfl_xor(acc[r][j], 32);
        if ((tid & 32) == 0) { const int wave = tid >> 6;
#pragma unroll
            for (int r = 0; r < 9; ++r) *(LAS f32x4*)&red[(wave * 9 + r) * 128 + tx * 4] = acc[r]; }
        __syncthreads();
        for (int o = tid; o < 9 * 128; o += 512) { const int r = o >> 7, cc = o & 127; float s = 0.f;
#pragma unroll
            for (int w = 0; w < 8; ++w) s += red[(w * 9 + r) * 128 + cc];
            p->mod[((size_t)l * 9 + r) * 12288 + cb * 128 + cc] = s + p->ada_b[l * 12288 + cb * 128 + cc]; }
        __syncthreads();
    }
}

struct TTile { const float* W; bf16_t* Wt; int K, N, tk, tn; };
__device__ __forceinline__ TTile tile_desc(KParams p, int it) {
    TTile t; const int l = it / 3136; int r = it % 3136; size_t off;
    if (r < 832) { t.W = p->w_in + (size_t)l * DM * NIN; t.K = DM; t.N = NIN; off = WT_IN; }
    else if (r < 1088) { r -= 832; t.W = p->w_out + (size_t)l * DM * DM; t.K = DM; t.N = DM; off = WT_OUT; }
    else if (r < 2112) { r -= 1088; t.W = p->w1 + (size_t)l * DM * HID; t.K = DM; t.N = HID; off = WT_1; }
    else { r -= 2112; t.W = p->w2 + (size_t)l * HID * DM; t.K = HID; t.N = DM; off = WT_2; }
    const int ntn = t.N / 128; t.tk = r / ntn; t.tn = r % ntn; t.Wt = p->wt + (size_t)l * WT_LAYER + off; return t;
}
__device__ __forceinline__ void tile_load(f32x4 (&v)[8], const TTile& t, int tid) {
    const int kr = tid >> 5, n4 = tid & 31;
#pragma unroll
    for (int i = 0; i < 8; ++i) v[i] = *(const f32x4*)(t.W + (size_t)(t.tk * 128 + kr + 16 * i) * t.N + t.tn * 128 + n4 * 4);
}
template <class F>
__device__ __forceinline__ void transpose_tiles(KParams p, LAS unsigned char* lds, int n_it, const F& tile_of) {
    const int tid = tid_o();
    LAS float* tile = (LAS float*)lds;
    if (n_it <= 0) return;
    f32x4 v[8];
    TTile cur = tile_desc(p, tile_of(0));
    tile_load(v, cur, tid);
    for (int it = 0; it < n_it; ++it) {
        { const int kr = tid >> 5, n4 = tid & 31;
#pragma unroll
          for (int i = 0; i < 8; ++i) { LAS float* t = tile + (kr + 16 * i) * 129 + n4 * 4; t[0] = v[i][0]; t[1] = v[i][1]; t[2] = v[i][2]; t[3] = v[i][3]; } }
        TTile nxt = cur;
        if (it + 1 < n_it) { nxt = tile_desc(p, tile_of(it + 1)); tile_load(v, nxt, tid); }
        __syncthreads();
        { const int nr = tid >> 4, k8 = tid & 15;
#pragma unroll
          for (int i = 0; i < 4; ++i) { const int n = nr + 32 * i; float f[8];
#pragma unroll
              for (int j = 0; j < 8; ++j) f[j] = tile[(k8 * 8 + j) * 129 + n];
              u32x4 w; w.x = cvt_pk_bf16(f[0], f[1]); w.y = cvt_pk_bf16(f[2], f[3]); w.z = cvt_pk_bf16(f[4], f[5]); w.w = cvt_pk_bf16(f[6], f[7]);
              *(u32x4*)(cur.Wt + (size_t)(cur.tn * 128 + n) * cur.K + cur.tk * 128 + k8 * 8) = w; } }
        __syncthreads();
        cur = nxt;
    }
}
__device__ void prepass(KParams p, LAS unsigned char* lds) {
    const int tid = tid_o(), bid = bid_o();
    if (bid < 192) { ada_prep(p, lds); ada_item(p, bid, lds); }
    const int n_it = bid < 192 ? 14 : 24;
    auto tile_of = [&](int k) { return k < 14 ? k * 256 + bid : 3584 + (k - 14) * 64 + (bid - 192); };
    int it = 0; const int it_end = n_it;
    transpose_tiles(p, lds, it_end, tile_of);
}

__device__ __forceinline__ const float* norm_src(KParams p, int l, bool from_input, int row) {
    return row < ML ? ((from_input ? p->x : p->out) + (size_t)row * DM) : (((from_input || l == 0) ? p->ctx : p->xc) + (size_t)(row - ML) * DM);
}
__device__ __forceinline__ void norm_phase(KParams p, int l, int which  , int M) {
    const int tid = tid_o(), wave = tid >> 6, lane = tid & 63;
    const float* nw = (which ? p->n2w : p->n1w) + l * DM;
    const bool from_input = (l == 0 && which == 0);
    const int g = bid_o() * 8 + wave, row0 = (g >> 8) * 2048 + (g & 255);
    const bool has_ctx = M > ML;
    f32x4 v[8], vn[8], wsc[8], sh[8];
    auto load_mod = [&](int r) { const float* md = p->mod + ((size_t)l * 9 + r) * 12288 + which * 6144;
#pragma unroll
        for (int i = 0; i < 8; ++i) { const int col = 4 * (lane + 64 * i); sh[i] = *(const f32x4*)(md + col); wsc[i] = *(const f32x4*)(nw + col) * (1.0f + *(const f32x4*)(md + 2048 + col)); } };
    auto finish = [&](int row) {
        float ss = 0.f;
#pragma unroll
        for (int i = 0; i < 8; ++i) ss += v[i][0] * v[i][0] + v[i][1] * v[i][1] + v[i][2] * v[i][2] + v[i][3] * v[i][3];
#pragma unroll
        for (int o = 32; o >= 1; o >>= 1) ss += __shfl_xor(ss, o);
        const float rstd = rsqrtf(ss * (1.0f / DM) + 1e-6f);
        bf16_t* dst = p->h + (size_t)row * DM;
#pragma unroll
        for (int i = 0; i < 8; ++i) { const int col = 4 * (lane + 64 * i);
            const f32x4 y = v[i] * rstd * wsc[i] + sh[i];
            u32x2 o; o.x = cvt_pk_bf16(y[0], y[1]); o.y = cvt_pk_bf16(y[2], y[3]); *(u32x2*)(dst + col) = o; } };
#pragma unroll
    for (int i = 0; i < 8; ++i) v[i] = *(const f32x4*)(norm_src(p, l, from_input, row0) + 4 * (lane + 64 * i));
    load_mod(g >> 8);
    for (int k = 0; k < 8; ++k) {
        const int row = row0 + 256 * k;
        if (k + 1 < 8 || has_ctx) { const int nrow = k + 1 < 8 ? row + 256 : ML + g;
#pragma unroll
            for (int i = 0; i < 8; ++i) vn[i] = *(const f32x4*)(norm_src(p, l, from_input, nrow) + 4 * (lane + 64 * i)); }
        finish(row);
#pragma unroll
        for (int i = 0; i < 8; ++i) v[i] = vn[i];
    }
    if (has_ctx) {
        const int row = ML + g;
        load_mod(8);
        const bool fold_mlp = (l == 1 && which == 0), fold_mix = (l == 0 && which == 1);
        if (fold_mlp || fold_mix) {
            const float* part = (fold_mlp ? (const float*)p->mix : (const float*)p->big) + (size_t)g * DM;
            const float* gt = p->mod + (size_t)8 * 12288 + (fold_mlp ? 10240 : 4096);
#pragma unroll
            for (int hf = 0; hf < 2; ++hf) {
                f32x4 pa[4], pb[4], pc[4], pd[4], gg[4];
#pragma unroll
                for (int i = 0; i < 4; ++i) { const int col = 4 * (lane + 64 * (4 * hf + i));
                    pa[i] = *(const f32x4*)(part + col); pb[i] = *(const f32x4*)(part + (size_t)MC * DM + col); pc[i] = *(const f32x4*)(part + (size_t)2 * MC * DM + col); pd[i] = *(const f32x4*)(part + (size_t)3 * MC * DM + col);
                    gg[i] = *(const f32x4*)(gt + col); }
#pragma unroll
                for (int i = 0; i < 4; ++i) v[4 * hf + i] += gg[i] * ((pa[i] + pb[i]) + (pc[i] + pd[i]));
            }
            if (fold_mix) {
                float* xo = p->xc + (size_t)g * DM;
#pragma unroll
                for (int i = 0; i < 8; ++i) *(f32x4*)(xo + 4 * (lane + 64 * i)) = v[i]; }
        }
        finish(row);
    }
}
__device__ void final_norm_phase(KParams p) {
    const int tid = tid_o(), wave = tid >> 6, lane = tid & 63;
    const int nrows = ML >> 11, row0 = bid_o() * 8 + wave;
    f32x4 v[8], vn[8], w[8];
#pragma unroll
    for (int i = 0; i < 8; ++i) { v[i] = *(const f32x4*)(p->out + (size_t)row0 * DM + 4 * (lane + 64 * i)); w[i] = *(const f32x4*)(p->fnw + 4 * (lane + 64 * i)); }
    for (int k = 0; k < nrows; ++k) {
        float* src = p->out + (size_t)(row0 + 2048 * k) * DM;
        if (k + 1 < nrows) {
#pragma unroll
            for (int i = 0; i < 8; ++i) vn[i] = *(const f32x4*)(src + (size_t)2048 * DM + 4 * (lane + 64 * i)); }
        float ss = 0.f;
#pragma unroll
        for (int i = 0; i < 8; ++i) ss += v[i][0] * v[i][0] + v[i][1] * v[i][1] + v[i][2] * v[i][2] + v[i][3] * v[i][3];
#pragma unroll
        for (int o = 32; o >= 1; o >>= 1) ss += __shfl_xor(ss, o);
        const float rstd = rsqrtf(ss * (1.0f / DM) + 1e-6f);
#pragma unroll
        for (int i = 0; i < 8; ++i) *(f32x4*)(src + 4 * (lane + 64 * i)) = v[i] * rstd * w[i];
#pragma unroll
        for (int i = 0; i < 8; ++i) v[i] = vn[i];
    }
}

constexpr int QS = 136, KES = 72;
__device__ __forceinline__ int hg_chunk_base(int b, int dir, int n) {
    if (n < 4) { const int ci = dir ? 3 - n : n; return ML + b * CT + ci * 64; }
    const int cn = n - 4; const int ci = dir ? 31 - cn : cn; return b * TL + ci * 64;
}
__device__ void hgA_item(KParams p, int l, int item, LAS unsigned char* lds) {
    const int tid = tid_o(), wid = tid >> 6, lane = tid & 63, fr = lane & 15, fq = lane >> 4;
    LAS bf16_t* QI = (LAS bf16_t*)lds;
    LAS bf16_t* KI = QI + 64 * QS;
    LAS bf16_t* KE = KI + 160 * QS;
    LAS bf16_t* VT = KE + 128 * KES;
    LAS float* F8 = (LAS float*)(VT + 128 * KES);
    LAS bf16_t* QFl = (LAS bf16_t*)(F8 + 1024);
    const int seq = item / 36, n = item - seq * 36;
    const int dir = seq & 1, hh = (seq >> 1) & 3, b = seq >> 3;
    const int dp = lane, tb = wid, I = tb >> 1;
    const int Iw = wid >> 1, vh = wid & 1;
    float lb[2] = {0.f, 0.f};
    if (l == 1) {
#pragma unroll
        for (int e = 0; e < 2; ++e) { const float l0 = p->lb_logits[dir * 512 + hh * 128 + 2 * dp + e], l1 = p->lb_logits[1024 + dir * 512 + hh * 128 + 2 * dp + e]; lb[e] = __builtin_amdgcn_rcpf(1.0f + __expf(l0 - l1)); } }
    const bf16_t* P = p->big;
    bf16_t* ohg = p->h + (size_t)dir * MT * 512;
    const int base = hg_chunk_base(b, dir, n);
    const bool skip_out = (l == 1 && n < 4);
    bf16_t* qfg = p->qfg + (size_t)item * 64 * 128;
    bf16_t* ug = p->ug + (size_t)item * 128 * 128;
    float pr[2][8], qv[2][8], kv[2][8];
    {
        unsigned xw[8], qw[8];
#pragma unroll
        for (int i = 0; i < 8; ++i) { const int tau = 8 * tb + i; const bf16_t* rowp = P + (size_t)(base + (dir ? 63 - tau : tau)) * NIN + hh * 128 + 2 * dp;
            xw[i] = *(const unsigned*)(rowp + C_HF + dir * 512); qw[i] = *(const unsigned*)(rowp + C_HQ); }
#pragma unroll
        for (int e = 0; e < 2; ++e) {
            const float omlb = 1.0f - lb[e];
            float run = 1.0f;
#pragma unroll
            for (int i = 0; i < 8; ++i) {
                const float x = e ? bfhi(xw[i]) : bflo(xw[i]), q = e ? bfhi(qw[i]) : bflo(qw[i]);
                const float ex = __expf(-fabsf(x));
                const float r = __builtin_amdgcn_rcpf(1.0f + ex);
                const float sp = x >= 0.f ? r : ex * r, sn = x >= 0.f ? ex * r : r;
                run *= lb[e] + omlb * sp;
                pr[e][i] = run;
                kv[e][i] = omlb * sn;
                qv[e][i] = q * __builtin_amdgcn_rcpf(1.0f + __expf(-q)) * 0.08838834764831845f;
            }
        }
        typedef float f32x2v __attribute__((ext_vector_type(2)));
        *(LAS f32x2v*)(F8 + tb * 128 + 2 * dp) = (f32x2v){pr[0][7], pr[1][7]};
    }
    { const int tau = tid >> 3, vc = tid & 7; const size_t row = (size_t)(base + (dir ? 63 - tau : tau));
      const bf16_t* srcv = P + row * NIN + C_HI + hh * 128 + 16 * vc;
      const u32x4 w0 = *(const u32x4*)srcv, w1 = *(const u32x4*)(srcv + 8);
      LAS bf16_t* dst = VT + (16 * vc) * KES + (tau ^ (8 * vc));
      dst[0 * KES] = (bf16_t)(w0.x & 0xffffu); dst[1 * KES] = (bf16_t)(w0.x >> 16); dst[2 * KES] = (bf16_t)(w0.y & 0xffffu); dst[3 * KES] = (bf16_t)(w0.y >> 16);
      dst[4 * KES] = (bf16_t)(w0.z & 0xffffu); dst[5 * KES] = (bf16_t)(w0.z >> 16); dst[6 * KES] = (bf16_t)(w0.w & 0xffffu); dst[7 * KES] = (bf16_t)(w0.w >> 16);
      dst[8 * KES] = (bf16_t)(w1.x & 0xffffu); dst[9 * KES] = (bf16_t)(w1.x >> 16); dst[10 * KES] = (bf16_t)(w1.y & 0xffffu); dst[11 * KES] = (bf16_t)(w1.y >> 16);
      dst[12 * KES] = (bf16_t)(w1.z & 0xffffu); dst[13 * KES] = (bf16_t)(w1.z >> 16); dst[14 * KES] = (bf16_t)(w1.w & 0xffffu); dst[15 * KES] = (bf16_t)(w1.w >> 16); }
    __syncthreads();
    {
        typedef float f32x2v __attribute__((ext_vector_type(2)));
        f32x2v F[8];
#pragma unroll
        for (int j = 0; j < 8; ++j) F[j] = *(const LAS f32x2v*)(F8 + j * 128 + 2 * dp);
        const f32x2v one = (f32x2v){1.0f, 1.0f};
        f32x2v eRI = one, eEnd = one, eK[4], hf = one;
#pragma unroll
        for (int j = 0; j < 8; ++j) { if (j < 2 * I) eRI *= F[j]; else eEnd *= F[j]; if (j == tb - 1 && (tb & 1)) hf = F[j]; }
        { f32x2v run = one;
#pragma unroll
          for (int Ip = 0; Ip < 4; ++Ip) { if (Ip > I) run *= F[2 * Ip - 2 < 0 ? 0 : 2 * Ip - 2] * F[2 * Ip - 1 < 0 ? 0 : 2 * Ip - 1]; eK[Ip] = run; } }
        unsigned kew[2][4];
#pragma unroll
        for (int i = 0; i < 8; ++i) {
            const int tau = 8 * tb + i;
            float qi[2], ke[2];
#pragma unroll
            for (int e = 0; e < 2; ++e) { const float ep = pr[e][i] * hf[e]; const float en = __builtin_amdgcn_rcpf(fmaxf(ep, 1.8e-35f)); qi[e] = qv[e][i] * ep; ke[e] = kv[e][i] * en; }
            *(LAS unsigned*)(QI + tau * QS + 2 * dp) = cvt_pk_bf16(qi[0], qi[1]);
            *(LAS unsigned*)(QFl + tau * QS + 2 * dp) = cvt_pk_bf16(qi[0] * eRI[0], qi[1] * eRI[1]);
#pragma unroll
            for (int Ip = 0; Ip < 4; ++Ip) if (Ip >= I) *(LAS unsigned*)(KI + (16 * ((Ip * (Ip + 1)) >> 1) + tau) * QS + 2 * dp) = cvt_pk_bf16(ke[0] * eK[Ip][0], ke[1] * eK[Ip][1]);
            const float k0 = ke[0] * eEnd[0], k1 = ke[1] * eEnd[1];
            if (i & 1) { kew[0][i >> 1] = cvt_pk_bf16(kv[0][i - 1], k0); kew[1][i >> 1] = cvt_pk_bf16(kv[1][i - 1], k1); } else { kv[0][i] = k0; kv[1][i] = k1; }
        }
#pragma unroll
        for (int e = 0; e < 2; ++e) { u32x4 w; w.x = kew[e][0]; w.y = kew[e][1]; w.z = kew[e][2]; w.w = kew[e][3]; *(LAS u32x4*)(KE + (2 * dp + e) * KES + 8 * tb) = w; }
        if (tb == 0) { typedef float f32x2g __attribute__((ext_vector_type(2))); *(f32x2g*)(p->aeg + (size_t)item * 128 + 2 * dp) = (f32x2g){eEnd[0], eEnd[1]}; }
    }
    __syncthreads();
#pragma unroll
    for (int k = 0; k < 4; ++k) { const int g = tid + 512 * k, ln = g & 63, half = (g >> 6) & 1, ks = (g >> 7) & 3, mt = g >> 9;
        const u32x2 w = *(const LAS u32x2*)(QFl + (16 * mt + (ln & 15)) * QS + 32 * ks + 16 * half + 4 * (ln >> 4));
        *(u32x2*)(qfg + (size_t)g * 4) = w; }
    if (!skip_out) {
        const int koff = 16 * ((Iw * (Iw + 1)) >> 1);
        bf16x8 qb[4];
#pragma unroll
        for (int ks = 0; ks < 4; ++ks) qb[ks] = *(const LAS bf16x8*)(QI + (16 * Iw + fr) * QS + 32 * ks + 8 * fq);
        f32x4 at[4];
#pragma unroll
        for (int J = 0; J < 4; ++J) {
            at[J] = (f32x4){0.f, 0.f, 0.f, 0.f};
            if (J <= Iw) {
#pragma unroll
                for (int ks = 0; ks < 4; ++ks) { const bf16x8 a = *(const LAS bf16x8*)(KI + (koff + 16 * J + fr) * QS + 32 * ks + 8 * fq); at[J] = __builtin_amdgcn_mfma_f32_16x16x32_bf16(a, qb[ks], at[J], 0, 0, 0); }
                mfma_settle(at[J]);
                if (J == Iw) {
#pragma unroll
                    for (int r = 0; r < 4; ++r) if (4 * fq + r > fr) at[J][r] = 0.f; }
            }
        }
        u32x4 aw[2];
#pragma unroll
        for (int kp = 0; kp < 2; ++kp) { aw[kp].x = cvt_pk_bf16(at[2 * kp][0], at[2 * kp][1]); aw[kp].y = cvt_pk_bf16(at[2 * kp][2], at[2 * kp][3]); aw[kp].z = cvt_pk_bf16(at[2 * kp + 1][0], at[2 * kp + 1][1]); aw[kp].w = cvt_pk_bf16(at[2 * kp + 1][2], at[2 * kp + 1][3]); }
#pragma unroll
        for (int nt = 0; nt < 4; ++nt) {
            const int vrow = vh * 64 + nt * 16 + fr;
            f32x4 oacc = (f32x4){0.f, 0.f, 0.f, 0.f};
#pragma unroll
            for (int kp = 0; kp < 2; ++kp) {
                const int sw = 8 * (vh * 4 + nt);
                const u32x2 b0 = *(const LAS u32x2*)(VT + vrow * KES + ((32 * kp + 4 * fq) ^ sw)), b1 = *(const LAS u32x2*)(VT + vrow * KES + ((32 * kp + 16 + 4 * fq) ^ sw));
                u32x4 bw; bw.x = b0.x; bw.y = b0.y; bw.z = b1.x; bw.w = b1.y;
                oacc = __builtin_amdgcn_mfma_f32_16x16x32_bf16(__builtin_bit_cast(bf16x8, aw[kp]), __builtin_bit_cast(bf16x8, bw), oacc, 0, 0, 0);
            }
            mfma_settle(oacc);
#pragma unroll
            for (int r = 0; r < 4; ++r) { const int tau = 16 * Iw + 4 * fq + r; const size_t row = (size_t)(base + (dir ? 63 - tau : tau));
                ohg[row * 512 + hh * 128 + vrow] = f2bf(oacc[r]); }
        }
    }
    {
        bf16x8 ka[2];
#pragma unroll
        for (int ks = 0; ks < 2; ++ks) ka[ks] = *(const LAS bf16x8*)(KE + (16 * wid + fr) * KES + 32 * ks + 8 * fq);
#pragma unroll
        for (int nt = 0; nt < 8; ++nt) {
            f32x4 u = (f32x4){0.f, 0.f, 0.f, 0.f};
#pragma unroll
            for (int ks = 0; ks < 2; ++ks) { const bf16x8 bv = *(const LAS bf16x8*)(VT + (16 * nt + fr) * KES + ((32 * ks + 8 * fq) ^ (8 * nt))); u = __builtin_amdgcn_mfma_f32_16x16x32_bf16(ka[ks], bv, u, 0, 0, 0); }
            mfma_settle(u);
            u32x2 o; o.x = cvt_pk_bf16(u[0], u[1]); o.y = cvt_pk_bf16(u[2], u[3]);
            *(u32x2*)(ug + ((nt * 8 + wid) * 64 + lane) * 4) = o;
        }
    }
    __syncthreads();
}

struct HgUA { u32x2 u[8]; f32x4 ae[8]; };
__device__ __forceinline__ void hgB_load_u(HgUA& s, KParams p, int c, int wid, int lane, int fq) {
    const bf16_t* ug = p->ug + (size_t)c * 128 * 128 + (wid * 8 * 64 + lane) * 4;
    const float* ae = p->aeg + (size_t)c * 128 + 4 * fq;
#pragma unroll
    for (int m = 0; m < 8; ++m) { s.u[m] = *(const u32x2*)(ug + m * 256); s.ae[m] = *(const f32x4*)(ae + 16 * m); }
}
__device__ void hgB_seq(KParams p, int l, int seq, LAS unsigned char* lds) {
    const int tid = tid_o(), wid = tid >> 6, lane = tid & 63, fr = lane & 15, fq = lane >> 4;
    const int dir = seq & 1, hh = (seq >> 1) & 3, b = seq >> 3;
    const int vs = wid >> 1, vt = wid & 1;
    bf16_t* oib = p->oib + (size_t)((dir * 4 + hh) * 4 + vs) * MT * 32 + vt * 16 + fr;
    f32x4 S[8];
#pragma unroll
    for (int m = 0; m < 8; ++m) S[m] = (f32x4){0.f, 0.f, 0.f, 0.f};
    const bf16_t* qsrc = p->qfg + (size_t)seq * 36 * 64 * 128 + tid * 16;
    u32x4 qr0[2], qr1[2];
    { const u32x4 a0 = *(const u32x4*)qsrc, a1 = *(const u32x4*)(qsrc + 8);
      *(LAS u32x4*)(lds + tid * 32) = a0; *(LAS u32x4*)(lds + tid * 32 + 16) = a1; }
    qr0[0] = *(const u32x4*)(qsrc + 8192); qr0[1] = *(const u32x4*)(qsrc + 8192 + 8);
    qr1[0] = *(const u32x4*)(qsrc + 2 * 8192); qr1[1] = *(const u32x4*)(qsrc + 2 * 8192 + 8);
    HgUA sA, sB;
    hgB_load_u(sA, p, seq * 36, wid, lane, fq); hgB_load_u(sB, p, seq * 36 + 1, wid, lane, fq);
    auto step = [&](HgUA& s, int n) {
        if (n + 1 < 36) { LAS unsigned char* d = lds + ((n + 1) % 3) * 16384 + tid * 32; *(LAS u32x4*)d = qr0[0]; *(LAS u32x4*)(d + 16) = qr0[1]; }
        qr0[0] = qr1[0]; qr0[1] = qr1[1];
        if (n + 3 < 36) { qr1[0] = *(const u32x4*)(qsrc + (size_t)(n + 3) * 8192); qr1[1] = *(const u32x4*)(qsrc + (size_t)(n + 3) * 8192 + 8); }
        __syncthreads();
        const bool skip_out = (l == 1 && n < 4);
        if (!skip_out) {
            const int base = hg_chunk_base(b, dir, n);
            const LAS unsigned char* qf = lds + (n % 3) * 16384 + lane * 8;
            u32x4 bw[4];
#pragma unroll
            for (int ks = 0; ks < 4; ++ks) { bw[ks].x = cvt_pk_bf16(S[2 * ks][0], S[2 * ks][1]); bw[ks].y = cvt_pk_bf16(S[2 * ks][2], S[2 * ks][3]); bw[ks].z = cvt_pk_bf16(S[2 * ks + 1][0], S[2 * ks + 1][1]); bw[ks].w = cvt_pk_bf16(S[2 * ks + 1][2], S[2 * ks + 1][3]); }
            f32x4 oacc[4];
#pragma unroll
            for (int mt = 0; mt < 4; ++mt) {
                oacc[mt] = (f32x4){0.f, 0.f, 0.f, 0.f};
#pragma unroll
                for (int ks = 0; ks < 4; ++ks) {
                    const u32x2 qa = *(const LAS u32x2*)(qf + ((mt * 4 + ks) * 2 + 0) * 512), qc = *(const LAS u32x2*)(qf + ((mt * 4 + ks) * 2 + 1) * 512);
                    u32x4 aw; aw.x = qa.x; aw.y = qa.y; aw.z = qc.x; aw.w = qc.y;
                    oacc[mt] = __builtin_amdgcn_mfma_f32_16x16x32_bf16(__builtin_bit_cast(bf16x8, aw), __builtin_bit_cast(bf16x8, bw[ks]), oacc[mt], 0, 0, 0);
                }
            }
            asm volatile("s_nop 7\n\ts_nop 7\n\ts_nop 3" : "+v"(oacc[0]), "+v"(oacc[1]), "+v"(oacc[2]), "+v"(oacc[3]));
#pragma unroll
            for (int mt = 0; mt < 4; ++mt)
#pragma unroll
                for (int r = 0; r < 4; ++r) { const int tau = 16 * mt + 4 * fq + r; oib[(size_t)(base + (dir ? 63 - tau : tau)) * 32] = f2bf(oacc[mt][r]); }
        }
#pragma unroll
        for (int m = 0; m < 8; ++m) {
            S[m][0] = S[m][0] * s.ae[m][0] + bflo(s.u[m].x); S[m][1] = S[m][1] * s.ae[m][1] + bfhi(s.u[m].x);
            S[m][2] = S[m][2] * s.ae[m][2] + bflo(s.u[m].y); S[m][3] = S[m][3] * s.ae[m][3] + bfhi(s.u[m].y);
        }
        if (n + 2 < 36) hgB_load_u(s, p, seq * 36 + n + 2, wid, lane, fq);
    };
    for (int n = 0; n < 36; n += 2) { step(sA, n); step(sB, n + 1); }
    asm volatile("s_waitcnt vmcnt(0)" ::: "memory");
    __syncthreads();
    if (threadIdx.x == 0) { __builtin_amdgcn_fence(__ATOMIC_RELEASE, "agent"); asm volatile("s_waitcnt vmcnt(0)" ::: "memory"); __hip_atomic_fetch_add(p->bar + 3456 + 64 * 3 + 16 * l, 1u, __ATOMIC_RELAXED, __HIP_MEMORY_SCOPE_AGENT); }
}

constexpr int VS = 72;
constexpr int NA_KT = 64 * QS * 2, NA_VT = 128 * VS * 2, NA_BUF = NA_KT + NA_VT;
__device__ void na_item(KParams p, int l, int item, LAS unsigned char* lds) {
    const int tid = tid_o(), wid = tid >> 6, lane = tid & 63, fr = lane & 15, fq = lane >> 4;
    LAS float* RPB = (LAS float*)(lds + 2 * NA_BUF);
    const bf16_t* P = p->big;
    const float LOG2E = 1.4426950408889634f;
    const bool is_lat = item < 512;
    int b, hh, g4 = 0;
    if (is_lat) { g4 = item & 7; hh = (item >> 3) & 7; b = item >> 6; } else { const int it = item - 512; hh = it & 7; b = it >> 3; }
    const int j = wid & 3;
    int rq[2] = {0, 0}, r0w[2] = {0, 0}, qtok0[2];
#pragma unroll
    for (int t = 0; t < 2; ++t) {
        if (is_lat) { rq[t] = 4 * g4 + (wid >> 2) + 2 * t; r0w[t] = min(max(rq[t] - 4, 0), 24); qtok0[t] = b * TL + rq[t] * 64 + 16 * j; }
        else qtok0[t] = ML + b * CT + t * 128 + 16 * wid;
    }
    const int r0a = min(max(4 * g4 - 4, 0), 24), r0b = min(max(4 * g4 + 3 - 4, 0), 24);
    const int nlat = is_lat ? (r0b + 8 - r0a) : 0, nst = nlat + 4;
    const int kst = (j == 0) ? 0 : (j == 1) ? 8 : (j == 2) ? 24 : 32;
    if (is_lat) { const float* rp_src = p->rpb + ((size_t)l * 8 + hh) * 465; for (int i = tid; i < 465; i += 512) RPB[i] = rp_src[i] * LOG2E; }
    bf16x8 qb[2][4];
#pragma unroll
    for (int t = 0; t < 2; ++t)
#pragma unroll
        for (int ks = 0; ks < 4; ++ks) qb[t][ks] = *(const bf16x8*)(P + (size_t)(qtok0[t] + fr) * NIN + C_NAQ + hh * 128 + 32 * ks + 8 * fq);
    float m_run[2] = {-INFINITY, -INFINITY}, l_run[2] = {0.f, 0.f};
    f32x4 O[2][8];
#pragma unroll
    for (int t = 0; t < 2; ++t)
#pragma unroll
        for (int m = 0; m < 8; ++m) O[t][m] = (f32x4){0.f, 0.f, 0.f, 0.f};
    const float sc2 = 0.08838834764831845f * LOG2E;
    const int qc = 16 * j + fr, wst = min(max(qc - 8, 0), 48);
    int dcolv[8]; unsigned vmask = 0u;
#pragma unroll
    for (int i = 0; i < 8; ++i) { const int kc2 = kst + 16 * (i >> 2) + 4 * fq + (i & 3); dcolv[i] = min(max(kc2 - qc, -15), 15) + 15; vmask |= ((kc2 >= wst) && (kc2 < wst + 16)) ? (1u << i) : 0u; }
    const int skey = tid >> 3, sc = tid & 7;
    auto stage_tok = [&](int st) { return st < nlat ? (b * TL + (r0a + st) * 64) : (ML + b * CT + 64 * (st - nlat)); };
    auto loadKV = [&](u32x4 (&k)[2], u32x4 (&v)[2], int st) {
        const bf16_t* srow = P + (size_t)(stage_tok(st) + skey) * NIN + hh * 128 + 16 * sc;
        k[0] = *(const u32x4*)(srow + C_NAK); k[1] = *(const u32x4*)(srow + C_NAK + 8);
        v[0] = *(const u32x4*)(srow + C_NAV); v[1] = *(const u32x4*)(srow + C_NAV + 8);
    };
    u32x4 kq0[2], vq0[2];
    loadKV(kq0, vq0, 0);

    for (int st = 0; st < nst; ++st) {
        const bool lat_st = st < nlat;
        const int rk = r0a + st;
        LAS bf16_t* KT = (LAS bf16_t*)(lds + (st & 1) * NA_BUF);
        LAS bf16_t* VT = (LAS bf16_t*)(lds + (st & 1) * NA_BUF + NA_KT);
        { *(LAS u32x4*)(KT + skey * QS + 16 * sc) = kq0[0]; *(LAS u32x4*)(KT + skey * QS + 16 * sc + 8) = kq0[1];
          const u32x4 w0 = vq0[0], w1 = vq0[1];
          LAS bf16_t* dst = VT + (16 * sc) * VS + (skey ^ (8 * sc));
          dst[0 * VS] = (bf16_t)(w0.x & 0xffffu); dst[1 * VS] = (bf16_t)(w0.x >> 16); dst[2 * VS] = (bf16_t)(w0.y & 0xffffu); dst[3 * VS] = (bf16_t)(w0.y >> 16);
          dst[4 * VS] = (bf16_t)(w0.z & 0xffffu); dst[5 * VS] = (bf16_t)(w0.z >> 16); dst[6 * VS] = (bf16_t)(w0.w & 0xffffu); dst[7 * VS] = (bf16_t)(w0.w >> 16);
          dst[8 * VS] = (bf16_t)(w1.x & 0xffffu); dst[9 * VS] = (bf16_t)(w1.x >> 16); dst[10 * VS] = (bf16_t)(w1.y & 0xffffu); dst[11 * VS] = (bf16_t)(w1.y >> 16);
          dst[12 * VS] = (bf16_t)(w1.z & 0xffffu); dst[13 * VS] = (bf16_t)(w1.z >> 16); dst[14 * VS] = (bf16_t)(w1.w & 0xffffu); dst[15 * VS] = (bf16_t)(w1.w >> 16); }
        if (st + 1 < nst) loadKV(kq0, vq0, st + 1);
        __syncthreads();
        bool act[2];
#pragma unroll
        for (int t = 0; t < 2; ++t) act[t] = lat_st ? (rk >= r0w[t] && rk < r0w[t] + 8) : true;
        if (act[0] || act[1]) {
            const int nsub = lat_st ? 1 : 2;
            for (int sub = 0; sub < nsub; ++sub) {
                const int k0 = lat_st ? kst : 32 * sub;
                bf16x8 kf[8];
#pragma unroll
                for (int a = 0; a < 2; ++a)
#pragma unroll
                    for (int ks = 0; ks < 4; ++ks) kf[a * 4 + ks] = *(const LAS bf16x8*)(KT + (k0 + 16 * a + fr) * QS + 32 * ks + 8 * fq);
                bf16x8 pb[2]; float mxv[2], s2keep[2][8]; bool grow = false;
#pragma unroll
                for (int t = 0; t < 2; ++t) {
                    f32x4 sa[2];
#pragma unroll
                    for (int a = 0; a < 2; ++a) {
                        sa[a] = (f32x4){0.f, 0.f, 0.f, 0.f};
#pragma unroll
                        for (int ks = 0; ks < 4; ++ks) sa[a] = __builtin_amdgcn_mfma_f32_16x16x32_bf16(kf[a * 4 + ks], qb[t][ks], sa[a], 0, 0, 0);
                    }
                    float s2[8];
                    if (lat_st) {
                        const LAS float* rpr = RPB + min(max(rk - rq[t] + 7, 0), 14) * 31;
                        const unsigned vm = act[t] ? vmask : 0u;
#pragma unroll
                        for (int i = 0; i < 8; ++i) s2[i] = rpr[dcolv[i]];
#pragma unroll
                        for (int i = 0; i < 8; ++i) s2[i] = (vm >> i) & 1 ? sa[i >> 2][i & 3] * sc2 + s2[i] : -INFINITY;
                    } else {
#pragma unroll
                        for (int i = 0; i < 8; ++i) s2[i] = sa[i >> 2][i & 3] * sc2;
                    }
                    float mx = s2[0];
#pragma unroll
                    for (int i = 1; i < 8; ++i) mx = fmaxf(mx, s2[i]);
                    mx = rowmax4(mx);
                    mxv[t] = mx;
                    grow |= (mx - m_run[t] > 8.0f);
                    s2keep[t][0] = s2[0]; s2keep[t][1] = s2[1]; s2keep[t][2] = s2[2]; s2keep[t][3] = s2[3]; s2keep[t][4] = s2[4]; s2keep[t][5] = s2[5]; s2keep[t][6] = s2[6]; s2keep[t][7] = s2[7];
                }
                if (__builtin_amdgcn_ballot_w64(grow) != 0ull) {
#pragma unroll
                    for (int t = 0; t < 2; ++t) {
                        const float m_new = fmaxf(m_run[t], mxv[t]);
                        const float m_safe = (m_new == -INFINITY) ? 0.f : m_new;
                        const float al = __builtin_amdgcn_exp2f(m_run[t] - m_safe);
                        l_run[t] *= al; m_run[t] = m_new;
#pragma unroll
                        for (int m = 0; m < 8; ++m) O[t][m] *= al;
                    }
                }
#pragma unroll
                for (int t = 0; t < 2; ++t) {
                    const float m_ref = (m_run[t] == -INFINITY) ? 0.f : m_run[t];
                    float ps = 0.f; float pe[8];
#pragma unroll
                    for (int i = 0; i < 8; ++i) { pe[i] = __builtin_amdgcn_exp2f(s2keep[t][i] - m_ref); ps += pe[i]; }
                    l_run[t] += ps;
                    u32x4 pw; pw.x = cvt_pk_bf16(pe[0], pe[1]); pw.y = cvt_pk_bf16(pe[2], pe[3]); pw.z = cvt_pk_bf16(pe[4], pe[5]); pw.w = cvt_pk_bf16(pe[6], pe[7]);
                    asm volatile("s_nop 4" : "+v"(pw));
                    pb[t] = __builtin_bit_cast(bf16x8, pw);
                }
#pragma unroll
                for (int m = 0; m < 8; ++m) {
                    const u32x2 a0 = *(const LAS u32x2*)(VT + (16 * m + fr) * VS + ((k0 + 4 * fq) ^ (8 * m))), a1 = *(const LAS u32x2*)(VT + (16 * m + fr) * VS + ((k0 + 16 + 4 * fq) ^ (8 * m)));
                    u32x4 aw; aw.x = a0.x; aw.y = a0.y; aw.z = a1.x; aw.w = a1.y;
#pragma unroll
                    for (int t = 0; t < 2; ++t) O[t][m] = __builtin_amdgcn_mfma_f32_16x16x32_bf16(__builtin_bit_cast(bf16x8, aw), pb[t], O[t][m], 0, 0, 0);
                }
            }
        }
    }
#pragma unroll
    for (int t = 0; t < 2; ++t) {
        const float lr = rowsum4(l_run[t]);
        const float inv = 1.0f / lr;
        bf16_t* dst = p->mix + (size_t)(qtok0[t] + fr) * DM + hh * 128 + 4 * fq;
#pragma unroll
        for (int m = 0; m < 8; ++m) { u32x2 o; o.x = cvt_pk_bf16(O[t][m][0] * inv, O[t][m][1] * inv); o.y = cvt_pk_bf16(O[t][m][2] * inv, O[t][m][3] * inv); *(u32x2*)(dst + 16 * m) = o; }
    }
    __syncthreads();
}

__device__ void gm_item(KParams p, int l, int item, LAS unsigned char* lds) {
    const int tid = tid_o(), wid = tid >> 6, lane = tid & 63, fr = lane & 15, fq = lane >> 4;
    LAS bf16_t* VNT = (LAS bf16_t*)lds;
    LAS bf16_t* WS = VNT + 128 * QS;
    const bf16_t* P = p->big;
    const int g = item & 3, row0 = (item >> 2) * 128;
    const int q = tid >> 2, part = tid & 3;
    const int pr = 16 * wid + fr;
    u32x4 vw[4]; f32x4 lwv[8], wsv[8]; u32x2 uwv[8];
    { const bf16_t* src = P + (size_t)(row0 + q) * NIN + C_GV + g * 128;
      const float* lw = p->gm_lnw + l * 512 + g * 128;
      const float* wsrc = p->gm_ws + (((size_t)l * 4 + g) * 128 + q) * 128;
#pragma unroll
      for (int i = 0; i < 4; ++i) { vw[i] = *(const u32x4*)(src + 8 * (part + 4 * i)); lwv[2 * i] = *(const f32x4*)(lw + 8 * (part + 4 * i)); lwv[2 * i + 1] = *(const f32x4*)(lw + 8 * (part + 4 * i) + 4); }
#pragma unroll
      for (int i = 0; i < 8; ++i) wsv[i] = *(const f32x4*)(wsrc + 4 * (part + 4 * i)); }
    const float bsv = p->gm_bs[(l * 4 + g) * 128 + pr];
    const bf16_t* usrc = P + (size_t)(row0 + pr) * NIN + C_GU + g * 128 + 4 * fq;
#pragma unroll
    for (int m = 0; m < 8; ++m) uwv[m] = *(const u32x2*)(usrc + 16 * m);
    {
        float vf[32];
#pragma unroll
        for (int i = 0; i < 4; ++i) { const u32x4 w = vw[i];
            vf[8 * i + 0] = gelu_tanh(bflo(w.x)); vf[8 * i + 1] = gelu_tanh(bfhi(w.x)); vf[8 * i + 2] = gelu_tanh(bflo(w.y)); vf[8 * i + 3] = gelu_tanh(bfhi(w.y));
            vf[8 * i + 4] = gelu_tanh(bflo(w.z)); vf[8 * i + 5] = gelu_tanh(bfhi(w.z)); vf[8 * i + 6] = gelu_tanh(bflo(w.w)); vf[8 * i + 7] = gelu_tanh(bfhi(w.w)); }
        float s = 0.f;
#pragma unroll
        for (int i = 0; i < 32; ++i) s += vf[i];
        s += __shfl_xor(s, 1); s += __shfl_xor(s, 2);
        const float mu = s * (1.0f / 128.0f);
        float qq = 0.f;
#pragma unroll
        for (int i = 0; i < 32; ++i) { const float dlt = vf[i] - mu; qq += dlt * dlt; }
        qq += __shfl_xor(qq, 1); qq += __shfl_xor(qq, 2);
        const float rstd = rsqrtf(qq * (1.0f / 128.0f) + 1e-6f);
        const int qs = q ^ (8 * part);
#pragma unroll
        for (int i = 0; i < 4; ++i)
#pragma unroll
            for (int e = 0; e < 8; ++e) VNT[(8 * (part + 4 * i) + e) * QS + qs] = f2bf((vf[8 * i + e] - mu) * rstd * lwv[2 * i + (e >> 2)][e & 3]);
#pragma unroll
        for (int i = 0; i < 8; ++i) { u32x2 w; w.x = cvt_pk_bf16(wsv[i][0], wsv[i][1]); w.y = cvt_pk_bf16(wsv[i][2], wsv[i][3]); *(LAS u32x2*)(WS + q * QS + 4 * (part + 4 * i)) = w; }
    }
    __syncthreads();
    {
        bf16x8 bfr[4];
#pragma unroll
        for (int ks = 0; ks < 4; ++ks) bfr[ks] = *(const LAS bf16x8*)(WS + (16 * wid + fr) * QS + 32 * ks + 8 * fq);
        bf16_t* dst = p->mix + (size_t)(row0 + pr) * DM + 1536 + g * 128 + 4 * fq;
#pragma unroll
        for (int m = 0; m < 8; ++m) {
            f32x4 acc = (f32x4){0.f, 0.f, 0.f, 0.f};
            const int sw = 8 * ((2 * m + (fr >> 3)) & 3);
#pragma unroll
            for (int ks = 0; ks < 4; ++ks) { const bf16x8 a = *(const LAS bf16x8*)(VNT + (16 * m + fr) * QS + ((32 * ks + 8 * fq) ^ sw)); acc = __builtin_amdgcn_mfma_f32_16x16x32_bf16(a, bfr[ks], acc, 0, 0, 0); }
            const u32x2 uw = uwv[m];
            const float o0 = gelu_tanh(bflo(uw.x)) * (acc[0] + bsv), o1 = gelu_tanh(bfhi(uw.x)) * (acc[1] + bsv), o2 = gelu_tanh(bflo(uw.y)) * (acc[2] + bsv), o3 = gelu_tanh(bfhi(uw.y)) * (acc[3] + bsv);
            u32x2 o; o.x = cvt_pk_bf16(o0, o1); o.y = cvt_pk_bf16(o2, o3); *(u32x2*)(dst + 16 * m) = o;
        }
    }
    __syncthreads();
}

__device__ void gatenorm_item(KParams p, int l, int item) {
    const int tid = tid_o(), wave = tid >> 6, lane = tid & 63;
    const bf16_t* o0 = p->h; const bf16_t* o1 = o0 + (size_t)MT * 512;
    const float* nw = p->hg_nw + l * 128 + 8 * (lane & 15);
    const f32x4 w0 = *(const f32x4*)nw, w1 = *(const f32x4*)(nw + 4);
    for (int half = 0; half < 2; ++half) {
        const int rbase = item * 64 + wave * 8 + 4 * half;
        u32x4 x0[4], x1[4], i0[4], i1[4], gw[4];
#pragma unroll
        for (int j = 0; j < 4; ++j) { const int row = rbase + j; const size_t off = (size_t)row * 512 + 8 * lane;
            const size_t ioff = ((size_t)(lane >> 2) * MT + row) * 32 + 8 * (lane & 3);
            x0[j] = *(const u32x4*)(o0 + off); x1[j] = *(const u32x4*)(o1 + off);
            i0[j] = *(const u32x4*)(p->oib + ioff); i1[j] = *(const u32x4*)(p->oib + (size_t)16 * MT * 32 + ioff);
            gw[j] = *(const u32x4*)(p->big + (size_t)row * NIN + C_HG + 8 * lane); }
#pragma unroll
        for (int j = 0; j < 4; ++j) { const int row = rbase + j;
            f32x4 a0, a1;
            a0[0] = bflo(x0[j].x) + bflo(x1[j].x) + bflo(i0[j].x) + bflo(i1[j].x); a0[1] = bfhi(x0[j].x) + bfhi(x1[j].x) + bfhi(i0[j].x) + bfhi(i1[j].x);
            a0[2] = bflo(x0[j].y) + bflo(x1[j].y) + bflo(i0[j].y) + bflo(i1[j].y); a0[3] = bfhi(x0[j].y) + bfhi(x1[j].y) + bfhi(i0[j].y) + bfhi(i1[j].y);
            a1[0] = bflo(x0[j].z) + bflo(x1[j].z) + bflo(i0[j].z) + bflo(i1[j].z); a1[1] = bfhi(x0[j].z) + bfhi(x1[j].z) + bfhi(i0[j].z) + bfhi(i1[j].z);
            a1[2] = bflo(x0[j].w) + bflo(x1[j].w) + bflo(i0[j].w) + bflo(i1[j].w); a1[3] = bfhi(x0[j].w) + bfhi(x1[j].w) + bfhi(i0[j].w) + bfhi(i1[j].w);
            float ss = a0[0] * a0[0] + a0[1] * a0[1] + a0[2] * a0[2] + a0[3] * a0[3] + a1[0] * a1[0] + a1[1] * a1[1] + a1[2] * a1[2] + a1[3] * a1[3];
            ss += __shfl_xor(ss, 1); ss += __shfl_xor(ss, 2); ss += __shfl_xor(ss, 4); ss += __shfl_xor(ss, 8);
            const float rstd = rsqrtf(ss * (1.0f / 128.0f) + 1e-6f);
            const u32x4 g = gw[j];
            const float g0 = silu_f(bflo(g.x)), g1 = silu_f(bfhi(g.x)), g2 = silu_f(bflo(g.y)), g3 = silu_f(bfhi(g.y)), g4 = silu_f(bflo(g.z)), g5 = silu_f(bfhi(g.z)), g6 = silu_f(bflo(g.w)), g7 = silu_f(bfhi(g.w));
            u32x4 o; o.x = cvt_pk_bf16(a0[0] * rstd * w0[0] * g0, a0[1] * rstd * w0[1] * g1); o.y = cvt_pk_bf16(a0[2] * rstd * w0[2] * g2, a0[3] * rstd * w0[3] * g3);
            o.z = cvt_pk_bf16(a1[0] * rstd * w1[0] * g4, a1[1] * rstd * w1[1] * g5); o.w = cvt_pk_bf16(a1[2] * rstd * w1[2] * g6, a1[3] * rstd * w1[3] * g7);
            *(u32x4*)(p->mix + (size_t)row * DM + 1024 + 8 * lane) = o; }
    }
}

__device__ void hgA_phase(KParams p, int l, LAS unsigned char* lds) {
    for (int it = bid_o(); it < 64 * 36; it += gridDim.x) hgA_item(p, l, it, lds);
}
__device__ void mixer_phase(KParams p, int l, LAS unsigned char* lds) {
    if (bid_o() < 64) hgB_seq(p, l, bid_o(), lds);
    const int n_na = (l == 0) ? 512 + 64 : 512, n_gm = (l == 0) ? 576 : 512, n_gn = ((l == 0) ? MT : ML) / 64;
    unsigned* ctr = p->bar + 3456 + 64 * l;
    unsigned* done = p->bar + 3456 + 64 * 3 + 16 * l;
    volatile LAS unsigned* slot = (volatile LAS unsigned*)(lds + 131072 + 16);
    bool gn_ready = false;
    int it = next_item(ctr, slot);
    while (it < n_na + n_gm + n_gn) {
        unsigned nxt = 0u;
        if (threadIdx.x == 0) nxt = atomicAdd(ctr, 1u);
        if (it < n_na) na_item(p, l, it, lds);
        else if (it < n_na + n_gm) gm_item(p, l, it - n_na, lds);
        else {
            if (!gn_ready) {
                if (threadIdx.x == 0) { unsigned sp = 0u;
                    while (__hip_atomic_load(done, __ATOMIC_RELAXED, __HIP_MEMORY_SCOPE_AGENT) < 64u && ++sp < (1u << 22)) __builtin_amdgcn_s_sleep(8);
                    __builtin_amdgcn_fence(__ATOMIC_ACQUIRE, "agent"); asm volatile("s_waitcnt vmcnt(0)" ::: "memory"); }
                __syncthreads(); gn_ready = true; }
            gatenorm_item(p, l, it - n_na - n_gm);
            __syncthreads();
        }
        if (threadIdx.x == 0) *slot = nxt;
        __syncthreads();
        it = (int)*slot;
    }
}

#define XB_TMO      128
#define XB_XCNT(j)  (256  + 64 * (j))
#define XB_XSUB(j)  (1280 + 64 * (j))
#define XB_XGEN(j)  (2304 + 64 * (j))
#define XB_TOP      3328
#define XB_TOPGEN   3392
#define XCD_BAR_WORDS 3456
#define XB_SPIN_CAP (1u << 18)
__device__ __forceinline__ unsigned xb_ld(unsigned* p)              { return __hip_atomic_load(p, __ATOMIC_RELAXED, __HIP_MEMORY_SCOPE_AGENT); }
__device__ __forceinline__ unsigned xb_add(unsigned* p, unsigned v) { return __hip_atomic_fetch_add(p, v, __ATOMIC_RELAXED, __HIP_MEMORY_SCOPE_AGENT); }
__device__ __forceinline__ unsigned xb_xcc_id() { return (unsigned)__builtin_amdgcn_s_getreg((3 << 11) | 20) & 0xFu; }
#define XB_SPIN(cond, bar) do { unsigned _sp = 0; while (cond) { __builtin_amdgcn_s_sleep(1); \
    if ((++_sp & 255u) == 0u) { if (xb_ld(&(bar)[XB_TMO])) break; if (_sp > XB_SPIN_CAP) { atomicAdd(&(bar)[XB_TMO], 1u); break; } } } } while (0)
struct XcdBarrier { unsigned* bar; unsigned x; volatile LAS unsigned* st; };
__device__ __forceinline__ XcdBarrier xcd_barrier_post(unsigned* bar, volatile LAS unsigned* st) {
    XcdBarrier b; b.bar = bar; b.x = xb_xcc_id(); b.st = st;
    if (threadIdx.x == 0) (void)xb_add(&bar[XB_XCNT(b.x)], 1u);
    return b;
}
__device__ __forceinline__ void xcd_barrier_complete(unsigned* bar, unsigned x, unsigned& nloc, unsigned& nx) {
    const unsigned G = gridDim.x * gridDim.y * gridDim.z;
    unsigned sum, cnt, mine, sp = 0u;
    for (;;) {
        sum = 0u; cnt = 0u; mine = 0u;
#pragma unroll
        for (unsigned j = 0; j < 16; ++j) { const unsigned c = xb_ld(&bar[XB_XCNT(j)]); sum += c; cnt += (c > 0u) ? 1u : 0u; mine = (j == x) ? c : mine; }
        if (sum == G) break;
        __builtin_amdgcn_s_sleep(1);
        if ((++sp & 255u) == 0u) { if (xb_ld(&bar[XB_TMO])) break; if (sp > XB_SPIN_CAP) { atomicAdd(&bar[XB_TMO], 1u); break; } }
    }
    nloc = mine > 0u ? mine : 1u; nx = cnt > 0u ? cnt : 1u;
}
__device__ __forceinline__ void xcd_barrier(const XcdBarrier& b) {
    asm volatile("s_waitcnt vmcnt(0)" ::: "memory");
    __syncthreads();
    if (threadIdx.x == 0) {
        unsigned* bar = b.bar;
        __builtin_amdgcn_s_waitcnt(0);
        unsigned nloc = b.st[0], nx = b.st[1];
        if (nloc == 0u) { xcd_barrier_complete(bar, b.x, nloc, nx); b.st[0] = nloc; b.st[1] = nx; }
        const unsigned old = xb_add(&bar[XB_XSUB(b.x)], 1u);
        const unsigned gen = old / nloc;
        if (old + 1u == (gen + 1u) * nloc) {
            __builtin_amdgcn_fence(__ATOMIC_RELEASE, "agent");
            asm volatile("s_waitcnt vmcnt(0)" ::: "memory");
            const unsigned og = xb_add(&bar[XB_TOP], 1u);
            const unsigned tg = og / nx;
            if (og + 1u == (tg + 1u) * nx) xb_add(&bar[XB_TOPGEN], 1u);
            else XB_SPIN(xb_ld(&bar[XB_TOPGEN]) == tg, bar);
            __builtin_amdgcn_fence(__ATOMIC_ACQUIRE, "agent");
            xb_add(&bar[XB_XGEN(b.x)], 1u);
            asm volatile("s_waitcnt vmcnt(0)" ::: "memory");
        } else {
            XB_SPIN(xb_ld(&bar[XB_XGEN(b.x)]) == gen, bar);
            __builtin_amdgcn_fence(__ATOMIC_ACQUIRE, "agent");
            asm volatile("s_waitcnt vmcnt(0)" ::: "memory");
        }
    }
    __syncthreads();
}

__device__ __forceinline__ void run_phase(KParams p, int ph, LAS unsigned char* lds) {
    if (ph == 0) { prepass(p, lds); return; }
    if (ph == NPHASE - 1) { final_norm_phase(p); return; }
    const int l = (ph - 1) / NPL, s = (ph - 1) % NPL;
    const int Mx = (l == 0) ? MT : ML;
    const bf16_t* wt = p->wt + (size_t)l * WT_LAYER;
    const float* modl = p->mod + (size_t)l * 9 * 12288;
    switch (s) {
    case 0: case 5: norm_phase(p, l, s == 5 ? 1 : 0, s == 5 ? Mx : MT); break;
    case 1: { pg8::EpiBf16<0> E; E.O = p->big; E.ldc = NIN; pg8::InOrder S; S.init((int)gridDim.x, bid_o(), l == 1); run_gemm_s(lds, p->h, wt + WT_IN, MT, NIN, DM, DM, S, E);
              if (l == 0 && bid_o() >= 80) {
                  const int b2 = bid_o() - 80; const int n_it = (2048 - b2 + 175) / 176;
                  transpose_tiles(p, lds, n_it, [&](int k) { return 4224 + b2 + 176 * k; }); } } break;
    case 2: hgA_phase(p, l, lds); break;
    case 3: mixer_phase(p, l, lds); break;
    case 4: { pg8::EpiRes E; E.src_lat = (l == 0) ? p->x : p->out; E.src_ctx = (l == 0) ? p->ctx : p->xc; E.dst_lat = p->out; E.dst_ctx = p->xc; E.gate = modl + 4096;
              run_gemm(lds, p->mix, wt + WT_OUT, ML, DM, DM, E);
              if (l == 0) {
                  pg8::EpiPart EP; EP.part = (float*)p->big; EP.Mp = MC; EP.ldc = DM;
                  pg8::SplitOrder S; S.init(MC, DM, 4, (int)gridDim.x, bid_o());
                  run_gemm_s(lds, p->mix + (size_t)ML * DM, wt + WT_OUT, MC, DM, DM / 4, DM, S, EP); } } break;
    case 6: { pg8::EpiBf16<1> E; E.O = p->big; E.ldc = HID; run_gemm(lds, p->h, wt + WT_1, Mx, HID, DM, E); } break;
    case 7: { pg8::EpiRes E; E.src_lat = p->out; E.src_ctx = p->xc; E.dst_lat = p->out; E.dst_ctx = p->xc; E.gate = modl + 10240;
              run_gemm(lds, p->big, wt + WT_2, ML, DM, HID, E);
              if (l == 0) {
                  pg8::EpiPart EP; EP.part = (float*)p->mix; EP.Mp = MC; EP.ldc = DM;
                  pg8::SplitOrder S; S.init(MC, DM, 4, (int)gridDim.x, bid_o());
                  run_gemm_s(lds, p->big + (size_t)ML * HID, wt + WT_2, MC, DM, HID / 4, HID, S, EP); } } break;
    }
}

#ifndef DUP_MASK
#define DUP_MASK 0
#endif
__global__ void __launch_bounds__(512, 2) mega(Params p_arg, int ph_lo, int ph_hi) {
    extern __shared__ __attribute__((aligned(16))) unsigned char shm[];
    LAS unsigned char* lds = (LAS unsigned char*)shm;
    volatile LAS unsigned* st = (volatile LAS unsigned*)(lds + 131072);
    if (threadIdx.x == 0) { st[0] = 0u; st[1] = 0u; }
    __syncthreads();
    XcdBarrier xb = xcd_barrier_post(p_arg.bar, st);
    for (int ph = ph_lo; ph < ph_hi; ++ph) {
        KParams p = (KParams)__builtin_amdgcn_kernarg_segment_ptr();
        asm volatile("" : "+s"(p));
        run_phase(p, ph, lds);
        if (DUP_MASK) { const int s = (ph - 1) % NPL; if (ph >= 1 && ph < NPHASE - 1 && ((DUP_MASK >> s) & 1)) { __syncthreads(); run_phase(p, ph, lds); } }
        if (ph + 1 < ph_hi) {
            if (ph_hi > NPHASE) { __threadfence(); cg::this_grid().sync(); }
            else xcd_barrier(xb);
        }
    }
}

extern "C" void kernel_launch(void* const* d_in, const int* in_sizes, int n_in, void* d_out, int out_size, void* d_ws, size_t ws_size, hipStream_t stream) {
    static int grid_blocks = 0;
    if (!grid_blocks) {
        hipFuncSetAttribute((const void*)mega, hipFuncAttributeMaxDynamicSharedMemorySize, LDS_BYTES);
        int dev = 0, cus = 0, per_cu = 0;
        hipGetDevice(&dev);
        hipDeviceGetAttribute(&cus, hipDeviceAttributeMultiprocessorCount, dev);
        hipOccupancyMaxActiveBlocksPerMultiprocessor(&per_cu, mega, 512, LDS_BYTES);
        if (per_cu < 1) per_cu = 1;
        grid_blocks = cus * 1;
        if (grid_blocks > 256) grid_blocks = 256;
    }
    Params p{};
    p.x = (const float*)d_in[0]; p.c = (const float*)d_in[1]; p.ctx = (const float*)d_in[2]; p.c_ctx = (const float*)d_in[3];
    p.ada_w = (const float*)d_in[4]; p.ada_b = (const float*)d_in[5]; p.n1w = (const float*)d_in[6]; p.n2w = (const float*)d_in[7];
    p.w_in = (const float*)d_in[8]; p.rpb = (const float*)d_in[9]; p.lb_logits = (const float*)d_in[10]; p.hg_nw = (const float*)d_in[11];
    p.gm_lnw = (const float*)d_in[12]; p.gm_ws = (const float*)d_in[13]; p.gm_bs = (const float*)d_in[14]; p.w_out = (const float*)d_in[15];
    p.w1 = (const float*)d_in[16]; p.w2 = (const float*)d_in[17]; p.fnw = (const float*)d_in[18];
    p.out = (float*)d_out;
    char* ws = (char*)d_ws; size_t o = 0;
    auto take = [&](size_t bytes) { char* r = ws + o; o += (bytes + 255) & ~(size_t)255; return r; };
    p.wt = (bf16_t*)take(2 * WT_LAYER * 2);
    p.xc = (float*)take((size_t)MC * DM * 4);
    p.h = (bf16_t*)take((size_t)MT * DM * 2);
    p.mix = (bf16_t*)take((size_t)MT * DM * 2);
    p.big = (bf16_t*)take((size_t)MT * HID * 2 + (size_t)60 * 1024 * 1024);
    { char* q = (char*)p.big + (size_t)MT * NIN * 2; p.ug = (bf16_t*)q; q += (size_t)2304 * 128 * 128 * 2; p.qfg = (bf16_t*)q; q += (size_t)2304 * 64 * 128 * 2; p.aeg = (float*)q; }
    p.mod = (float*)take((size_t)2 * 9 * 12288 * 4);
    p.oib = (bf16_t*)take((size_t)2 * MT * 512 * 2);
    p.bar = (unsigned*)take((size_t)(XCD_BAR_WORDS + 256) * 4);
    if (o > ws_size) { fprintf(stderr, "workspace too small: need %zu have %zu\n", o, ws_size); return; }
    if (hipMemsetAsync(p.bar, 0, (size_t)(XCD_BAR_WORDS + 256) * 4, stream) != hipSuccess) { fprintf(stderr, "memset failed\n"); return; }
#if ONE_LAUNCH
    int lo = 0, hi = NPHASE;
    void* args[] = {&p, &lo, &hi};
    hipError_t e = hipLaunchCooperativeKernel((const void*)mega, dim3(grid_blocks), dim3(512), args, LDS_BYTES, stream);
    if (e != hipSuccess) fprintf(stderr, "cooperative launch failed: %s (grid %d)\n", hipGetErrorString(e), grid_blocks);
#else
    for (int ph = 0; ph < NPHASE; ++ph) hipLaunchKernelGGL(mega, dim3(grid_blocks), dim3(512), LDS_BYTES, stream, p, ph, ph + 1);
#endif
}
```
